# Optimizing an MI355X kernel written in HIP

```python
import jax, jax.numpy as jnp
from jax import lax
import numpy as np

D_MODEL = 1024
BATCH = 2
SEQ = 8192
DEPTH = 2

N_META = 16
FOX_HEADS = 16
FOX_HEAD_DIM = D_MODEL // FOX_HEADS
Q_BLOCK = 128
HGRN_EXPAND = 128
HGRN_HEADS = D_MODEL // HGRN_EXPAND
HGRN_CHUNK = 64
D_FF = ((8 * D_MODEL // 3 + 127) // 128) * 128
CONV_WIDTH = 3
EPS = 1e-6
N_FOX_LAYERS = (DEPTH + 1) // 2
N_HGRN_LAYERS = DEPTH // 2

kernel_name = "fox_hgrn2_interleaved_convffn"


def rms_norm(x, gain):
    x32 = x.astype(jnp.float32)
    y = x32 * lax.rsqrt(jnp.mean(x32 * x32, axis=-1, keepdims=True) + EPS)
    return (y * gain.astype(jnp.float32)).astype(x.dtype)


def fox_attention(h, norm_g, w_in, b_f, q_gain, k_gain, w_out):
    B, L, D = h.shape
    H, hd = FOX_HEADS, FOX_HEAD_DIM
    xn = rms_norm(h, norm_g)
    q, k, v, f_logit, o_gate = jnp.split(xn @ w_in, [D, 2 * D, 3 * D, 3 * D + H], axis=-1)
    q = rms_norm(q.reshape(B, L, H, hd), q_gain).astype(jnp.float32) * (hd ** -0.5)
    k = rms_norm(k.reshape(B, L, H, hd), k_gain).astype(jnp.float32)
    v = v.reshape(B, L, H, hd)
    log_f = jax.nn.log_sigmoid((f_logit + b_f).astype(jnp.float32))
    c = jnp.cumsum(log_f, axis=1).transpose(0, 2, 1)
    key_pos = jnp.arange(L)

    def attend(q_blk, c_blk, q_pos):
        s = jnp.einsum('bqhd,bkhd->bhqk', q_blk, k)
        s = s + c_blk[..., None] - c[:, :, None, :]
        s = jnp.where(q_pos[:, None] >= key_pos[None, :], s, -jnp.inf)
        p = jax.nn.softmax(s, axis=-1)
        return jnp.einsum('bhqk,bkhd->bqhd', p.astype(v.dtype), v)

    o_meta = attend(q[:, :N_META], c[:, :, :N_META], jnp.arange(N_META))
    n_blk = (L - N_META) // Q_BLOCK
    q_r = q[:, N_META:].reshape(B, n_blk, Q_BLOCK, H, hd).transpose(1, 0, 2, 3, 4)
    c_r = c[:, :, N_META:].reshape(B, H, n_blk, Q_BLOCK).transpose(2, 0, 1, 3)
    pos_r = (N_META + jnp.arange(L - N_META)).reshape(n_blk, Q_BLOCK)
    o_r = lax.map(lambda a: attend(*a), (q_r, c_r, pos_r))
    o_r = o_r.transpose(1, 0, 2, 3, 4).reshape(B, L - N_META, H, hd)
    o = jnp.concatenate([o_meta, o_r], axis=1).reshape(B, L, D)
    o = o * jax.nn.sigmoid(o_gate)
    return o @ w_out


def hgrn2_chunk(S, q, k, v, log_f):
    C = q.shape[2]
    b = jnp.cumsum(log_f, axis=2)
    causal = jnp.arange(C)[:, None] >= jnp.arange(C)[None, :]
    diff = b[:, :, :, None, :] - b[:, :, None, :, :]
    decay = jnp.exp(jnp.where(causal[None, None, :, :, None], diff, -jnp.inf))
    scores = jnp.einsum('bhtk,bhtsk,bhsk->bhts', q, decay, k)
    o = jnp.einsum('bhts,bhsv->bhtv', scores, v) + jnp.einsum('bhtk,bhkv->bhtv', q * jnp.exp(b), S)
    b_end = b[:, :, -1]
    S_new = jnp.exp(b_end)[..., None] * S + jnp.einsum(
        'bhsk,bhsv->bhkv', k * jnp.exp(b_end[:, :, None, :] - b), v)
    return S_new, o


def hgrn2_mixer(h, norm_g, w_in, lower_bound, o_gain, w_out):
    B, L, D = h.shape
    H, dk = HGRN_HEADS, HGRN_EXPAND
    xn = rms_norm(h, norm_g)
    q, f_logit, i, g = jnp.split(xn @ w_in, 4, axis=-1)
    lb = lower_bound.astype(jnp.float32)
    f = lb + (1.0 - lb) * jax.nn.sigmoid(f_logit.astype(jnp.float32))

    def to_heads(t):
        return t.astype(jnp.float32).reshape(B, L, H, dk).transpose(0, 2, 1, 3)

    q = to_heads(jax.nn.silu(q))
    k = to_heads(1.0 - f)
    log_f = to_heads(jnp.log(f))
    v = to_heads(i)
    S0 = jnp.zeros((B, H, dk, dk), jnp.float32)
    S, o_meta = hgrn2_chunk(S0, q[:, :, :N_META], k[:, :, :N_META], v[:, :, :N_META], log_f[:, :, :N_META])
    n_chunk = (L - N_META) // HGRN_CHUNK

    def chunks(t):
        return t[:, :, N_META:].reshape(B, H, n_chunk, HGRN_CHUNK, dk).transpose(2, 0, 1, 3, 4)

    _, o_r = lax.scan(lambda s, a: hgrn2_chunk(s, *a), S, (chunks(q), chunks(k), chunks(v), chunks(log_f)))
    o_r = o_r.transpose(1, 2, 0, 3, 4).reshape(B, H, L - N_META, dk)
    o = jnp.concatenate([o_meta, o_r], axis=2).transpose(0, 2, 1, 3)
    o = rms_norm(o, o_gain).reshape(B, L, D) * jax.nn.sigmoid(g.astype(jnp.float32))
    return o.astype(h.dtype) @ w_out


def conv_ffn(h, norm_g, w_gate, w_up, conv_w, conv_b, w_down):
    xn = rms_norm(h, norm_g)
    a = xn @ w_gate
    L = a.shape[1]
    a_pad = jnp.pad(a, ((0, 0), (CONV_WIDTH - 1, 0), (0, 0)))
    a = (conv_b + conv_w[0] * a_pad[:, 0:L] + conv_w[1] * a_pad[:, 1:L + 1]
         + conv_w[2] * a_pad[:, 2:L + 2])
    return (jax.nn.silu(a) * (xn @ w_up)) @ w_down


def setup_inputs(seed: int = 0) -> dict:
    key = jax.random.key(seed)
    ks = jax.random.split(key, 19)
    D, F, H = D_MODEL, D_FF, FOX_HEADS
    nF, nH = N_FOX_LAYERS, N_HGRN_LAYERS

    def normal(k, shape, scale):
        return scale * jax.random.normal(k, shape, jnp.float32)

    def gain(k, shape):
        return 1.0 + normal(k, shape, 0.05)

    return {
        "x": normal(ks[0], (BATCH, SEQ, D), 1.0),
        "meta_tokens": normal(ks[1], (N_META, D), 1.0),
        "fox_norm": gain(ks[2], (nF, D)),
        "fox_w_in": normal(ks[3], (nF, D, 4 * D + H), D ** -0.5),
        "fox_b_f": 2.0 + normal(ks[4], (nF, H), 0.1),
        "fox_q_gain": gain(ks[5], (nF, FOX_HEAD_DIM)),
        "fox_k_gain": gain(ks[6], (nF, FOX_HEAD_DIM)),
        "fox_w_out": normal(ks[7], (nF, D, D), D ** -0.5),
        "hgrn_norm": gain(ks[8], (nH, D)),
        "hgrn_w_in": normal(ks[9], (nH, D, 4 * D), D ** -0.5),
        "hgrn_lower_bounds": normal(ks[10], (DEPTH, D), 0.1),
        "hgrn_o_gain": gain(ks[11], (nH, HGRN_EXPAND)),
        "hgrn_w_out": normal(ks[12], (nH, D, D), D ** -0.5),
        "ffn_norm": gain(ks[13], (DEPTH, D)),
        "ffn_w_gate": normal(ks[14], (DEPTH, D, F), D ** -0.5),
        "ffn_w_up": normal(ks[15], (DEPTH, D, F), D ** -0.5),
        "ffn_conv_w": normal(ks[16], (DEPTH, CONV_WIDTH, F), CONV_WIDTH ** -0.5),
        "ffn_conv_b": normal(ks[17], (DEPTH, F), 0.02),
        "ffn_w_down": normal(ks[18], (DEPTH, F, D), F ** -0.5),
    }


def reference(x, meta_tokens, fox_norm, fox_w_in, fox_b_f, fox_q_gain, fox_k_gain, fox_w_out,
              hgrn_norm, hgrn_w_in, hgrn_lower_bounds, hgrn_o_gain, hgrn_w_out,
              ffn_norm, ffn_w_gate, ffn_w_up, ffn_conv_w, ffn_conv_b, ffn_w_down):
    B = x.shape[0]
    meta = jnp.broadcast_to(meta_tokens[None].astype(x.dtype), (B, N_META, D_MODEL))
    h = jnp.concatenate([meta, x], axis=1)
    p_lb = jax.nn.softmax(hgrn_lower_bounds.astype(jnp.float32), axis=0)
    lower_bounds = jnp.cumsum(p_lb, axis=0) - p_lb[0]
    for layer in range(DEPTH):
        j = layer // 2
        if layer % 2 == 0:
            h = h + fox_attention(h, fox_norm[j], fox_w_in[j], fox_b_f[j], fox_q_gain[j],
                                  fox_k_gain[j], fox_w_out[j])
        else:
            h = h + hgrn2_mixer(h, hgrn_norm[j], hgrn_w_in[j], lower_bounds[layer],
                                hgrn_o_gain[j], hgrn_w_out[j])
        h = h + conv_ffn(h, ffn_norm[layer], ffn_w_gate[layer], ffn_w_up[layer],
                         ffn_conv_w[layer], ffn_conv_b[layer], ffn_w_down[layer])
    return h[:, N_META:]
```

```cpp
#include <hip/hip_runtime.h>
#include <cstdint>
#include <cstdio>

typedef short bf16x8 __attribute__((ext_vector_type(8)));
typedef float f32x4 __attribute__((ext_vector_type(4)));

constexpr int NB = 2, SEQ = 8192, NMETA = 16, L = SEQ + NMETA, D = 1024, H = 16, HD = 64, FF = 2816, HH = 8, DK = 128;
constexpr int NIN = 4 * D + H;
constexpr float EPS = 1e-6f;

__device__ __forceinline__ unsigned short f2bf(float f) { unsigned u = __float_as_uint(f); return (unsigned short)((u + 0x7fffu + ((u >> 16) & 1u)) >> 16); }
__device__ __forceinline__ float wave_sum(float v) {
#pragma unroll
    for (int o = 1; o < 64; o <<= 1) v += __shfl_xor(v, o);
    return v;
}
__device__ __forceinline__ float wave_max(float v) {
#pragma unroll
    for (int o = 1; o < 64; o <<= 1) v = fmaxf(v, __shfl_xor(v, o));
    return v;
}
__device__ __forceinline__ float sigmoidf_(float x) { return 1.f / (1.f + __expf(-x)); }

__global__ void build_h(const float* __restrict__ x, const float* __restrict__ meta, float* __restrict__ Hb) {
    const int t = blockIdx.x;
    const float* src = t < NMETA ? meta + (size_t)t * D : x + (size_t)(t - NMETA) * D;
    for (int i = threadIdx.x; i < D; i += blockDim.x) Hb[(size_t)t * D + i] = src[i];
}
__global__ void write_out(const float* __restrict__ Hb, float* __restrict__ out) {
    const int t = blockIdx.x;
    for (int i = threadIdx.x; i < D; i += blockDim.x) out[(size_t)t * D + i] = Hb[(size_t)(t + NMETA) * D + i];
}
__global__ void rmsnorm_rows(const float* __restrict__ X, const float* __restrict__ g, float* __restrict__ Y) {
    const int r = blockIdx.x, lane = threadIdx.x;
    const float* x = X + (size_t)r * D;
    float v[16]; float s = 0.f;
#pragma unroll
    for (int j = 0; j < 16; ++j) { v[j] = x[lane + 64 * j]; s += v[j] * v[j]; }
    s = wave_sum(s);
    const float rs = rsqrtf(s * (1.f / D) + EPS);
#pragma unroll
    for (int j = 0; j < 16; ++j) Y[(size_t)r * D + lane + 64 * j] = v[j] * rs * g[lane + 64 * j];
}

__global__ __launch_bounds__(256) void gemm_naive(const float* __restrict__ A, int lda, const float* __restrict__ W, int ldw, float* C, int ldc,
                                                  const float* R, int M, int N, int K) {
    __shared__ __attribute__((aligned(16))) unsigned short sA[64][40];
    __shared__ __attribute__((aligned(16))) unsigned short sB[64][40];
    const int tid = threadIdx.x, wave = tid >> 6, lane = tid & 63;
    const int m0 = blockIdx.y * 64, n0 = blockIdx.x * 64;
    const int wr = wave >> 1, wc = wave & 1;
    f32x4 acc[2][2];
#pragma unroll
    for (int i = 0; i < 2; ++i)
#pragma unroll
        for (int j = 0; j < 2; ++j) acc[i][j] = (f32x4){0.f, 0.f, 0.f, 0.f};
    for (int k0 = 0; k0 < K; k0 += 32) {
        {
            const int r = tid >> 2, ks = (tid & 3) * 8, gr = m0 + r;
            float v[8];
#pragma unroll
            for (int j = 0; j < 8; ++j) v[j] = 0.f;
            if (gr < M) {
                const float* p = A + (size_t)gr * lda + k0 + ks;
#pragma unroll
                for (int j = 0; j < 8; ++j) v[j] = p[j];
            }
#pragma unroll
            for (int j = 0; j < 8; ++j) sA[r][ks + j] = f2bf(v[j]);
        }
        {
            const int k = tid >> 3, ns = (tid & 7) * 8;
            const float* p = W + (size_t)(k0 + k) * ldw + n0 + ns;
#pragma unroll
            for (int j = 0; j < 8; ++j) { const float w = (n0 + ns + j < N) ? p[j] : 0.f; sB[ns + j][k] = f2bf(w); }
        }
        __syncthreads();
        bf16x8 a[2], b[2];
#pragma unroll
        for (int i = 0; i < 2; ++i) a[i] = *(const bf16x8*)&sA[wr * 32 + i * 16 + (lane & 15)][(lane >> 4) * 8];
#pragma unroll
        for (int j = 0; j < 2; ++j) b[j] = *(const bf16x8*)&sB[wc * 32 + j * 16 + (lane & 15)][(lane >> 4) * 8];
#pragma unroll
        for (int i = 0; i < 2; ++i)
#pragma unroll
            for (int j = 0; j < 2; ++j) acc[i][j] = __builtin_amdgcn_mfma_f32_16x16x32_bf16(a[i], b[j], acc[i][j], 0, 0, 0);
        __syncthreads();
    }
#pragma unroll
    for (int i = 0; i < 2; ++i)
#pragma unroll
        for (int j = 0; j < 2; ++j)
#pragma unroll
            for (int e = 0; e < 4; ++e) {
                const int row = m0 + wr * 32 + i * 16 + (lane >> 4) * 4 + e, col = n0 + wc * 32 + j * 16 + (lane & 15);
                if (row < M && col < N) { float v = acc[i][j][e]; if (R) v += R[(size_t)row * ldc + col]; C[(size_t)row * ldc + col] = v; }
            }
}

__global__ void fox_prep(float* P, const float* __restrict__ gq, const float* __restrict__ gk, const float* __restrict__ bf, float* __restrict__ LF) {
    const int t = blockIdx.x, lane = threadIdx.x;
    float* row = P + (size_t)t * NIN;
    for (int h = 0; h < H; ++h) {
        float q = row[h * HD + lane];
        float ss = wave_sum(q * q);
        row[h * HD + lane] = q * rsqrtf(ss * (1.f / HD) + EPS) * gq[lane] * 0.125f;
        float k = row[D + h * HD + lane];
        ss = wave_sum(k * k);
        row[D + h * HD + lane] = k * rsqrtf(ss * (1.f / HD) + EPS) * gk[lane];
    }
    if (lane < H) {
        const float xx = row[3 * D + lane] + bf[lane];
        LF[(size_t)lane * L + t] = fminf(xx, 0.f) - log1pf(__expf(-fabsf(xx)));
    }
}
__global__ __launch_bounds__(1024) void cumsum_rows(const float* __restrict__ LF, float* __restrict__ Cc) {
    __shared__ float sh[1024];
    const int h = blockIdx.x, tid = threadIdx.x;
    constexpr int PER = (L + 1023) / 1024;
    float v[PER]; float s = 0.f;
#pragma unroll
    for (int j = 0; j < PER; ++j) { const int t = tid * PER + j; v[j] = t < L ? LF[(size_t)h * L + t] : 0.f; s += v[j]; }
    sh[tid] = s; __syncthreads();
    for (int o = 1; o < 1024; o <<= 1) { float a = tid >= o ? sh[tid - o] : 0.f; __syncthreads(); sh[tid] += a; __syncthreads(); }
    float run = sh[tid] - s;
#pragma unroll
    for (int j = 0; j < PER; ++j) { const int t = tid * PER + j; run += v[j]; if (t < L) Cc[(size_t)h * L + t] = run; }
}
__global__ __launch_bounds__(64) void fox_attn_naive(const float* __restrict__ P, const float* __restrict__ Cc, float* __restrict__ O) {
    const int t = blockIdx.x, h = blockIdx.y, lane = threadIdx.x;
    const float* q = P + (size_t)t * NIN + h * HD;
    float qv[HD];
#pragma unroll
    for (int d = 0; d < HD; ++d) qv[d] = q[d];
    const float ct = Cc[(size_t)h * L + t];
    float m = -INFINITY, l = 0.f, o = 0.f;
    for (int s0 = 0; s0 <= t; s0 += 64) {
        const int s = s0 + lane; float sc = -INFINITY;
        if (s <= t) {
            const float4* k = (const float4*)(P + (size_t)s * NIN + D + h * HD);
            float dot = 0.f;
#pragma unroll
            for (int d = 0; d < HD / 4; ++d) { const float4 kk = k[d]; dot += qv[4 * d] * kk.x + qv[4 * d + 1] * kk.y + qv[4 * d + 2] * kk.z + qv[4 * d + 3] * kk.w; }
            sc = dot + ct - Cc[(size_t)h * L + s];
        }
        const float mnew = fmaxf(m, wave_max(sc));
        const float p = (s <= t) ? __expf(sc - mnew) : 0.f;
        const float alpha = __expf(m - mnew);
        l = l * alpha + wave_sum(p); o *= alpha;
        const int cnt = min(64, t - s0 + 1);
        for (int j = 0; j < cnt; ++j) { const float pj = __shfl(p, j); o += pj * P[(size_t)(s0 + j) * NIN + 2 * D + h * HD + lane]; }
        m = mnew;
    }
    O[(size_t)t * D + h * HD + lane] = o / l;
}
__global__ void fox_gate(float* __restrict__ O, const float* __restrict__ P) {
    const int t = blockIdx.x;
    for (int i = threadIdx.x; i < D; i += blockDim.x) O[(size_t)t * D + i] *= sigmoidf_(P[(size_t)t * NIN + 3 * D + H + i]);
}
__global__ void ffn_ew(const float* __restrict__ A, float* __restrict__ U, const float* __restrict__ cw, const float* __restrict__ cb) {
    const int t = blockIdx.x;
    for (int f = threadIdx.x; f < FF; f += blockDim.x) {
        float a = cb[f] + cw[2 * FF + f] * A[(size_t)t * FF + f];
        if (t >= 1) a += cw[FF + f] * A[(size_t)(t - 1) * FF + f];
        if (t >= 2) a += cw[f] * A[(size_t)(t - 2) * FF + f];
        const float s = a * sigmoidf_(a);
        U[(size_t)t * FF + f] = s * U[(size_t)t * FF + f];
    }
}
__global__ void hgrn_prep(float* P, const float* __restrict__ lbraw) {
    const int t = blockIdx.x;
    float* row = P + (size_t)t * 4 * D;
    for (int i = threadIdx.x; i < D; i += blockDim.x) {
        const float q = row[i]; row[i] = q * sigmoidf_(q);
        const float lb = sigmoidf_(lbraw[D + i] - lbraw[i]);
        row[D + i] = lb + (1.f - lb) * sigmoidf_(row[D + i]);
        row[3 * D + i] = sigmoidf_(row[3 * D + i]);
    }
}
__global__ __launch_bounds__(64) void hgrn_rec_naive(const float* __restrict__ P, float* __restrict__ O) {
    const int h = blockIdx.x >> 1, j = (blockIdx.x & 1) * 64 + threadIdx.x;
    float S[DK];
#pragma unroll
    for (int k = 0; k < DK; ++k) S[k] = 0.f;
    for (int t = 0; t < L; ++t) {
        const float* row = P + (size_t)t * 4 * D;
        const float v = row[2 * D + h * DK + j];
        float o = 0.f;
#pragma unroll
        for (int k = 0; k < DK; ++k) {
            const float f = row[D + h * DK + k], qs = row[h * DK + k];
            S[k] = f * S[k] + (1.f - f) * v;
            o += S[k] * qs;
        }
        O[(size_t)t * D + h * DK + j] = o;
    }
}
__global__ __launch_bounds__(64) void hgrn_post(float* __restrict__ O, const float* __restrict__ P, const float* __restrict__ og) {
    const int t = blockIdx.x, h = blockIdx.y, lane = threadIdx.x;
    float* o = O + (size_t)t * D + h * DK;
    const float a = o[lane], b = o[lane + 64];
    const float ss = wave_sum(a * a + b * b);
    const float rs = rsqrtf(ss * (1.f / DK) + EPS);
    const float* g = P + (size_t)t * 4 * D + 3 * D + h * DK;
    o[lane] = a * rs * og[lane] * g[lane];
    o[lane + 64] = b * rs * og[lane + 64] * g[lane + 64];
}

static void gemm(const float* A, int lda, const float* W, int ldw, float* C, int ldc, const float* R, int M, int N, int K, hipStream_t st) {
    dim3 grid((N + 63) / 64, (M + 63) / 64);
    hipLaunchKernelGGL(gemm_naive, grid, dim3(256), 0, st, A, lda, W, ldw, C, ldc, R, M, N, K);
}

extern "C" void kernel_launch(void* const* d_in, const int* in_sizes, int n_in, void* d_out, int out_size, void* d_ws, size_t ws_size, hipStream_t stream) {
    const float* x = (const float*)d_in[0];
    const float* meta = (const float*)d_in[1];
    const float* fox_norm = (const float*)d_in[2];
    const float* fox_w_in = (const float*)d_in[3];
    const float* fox_b_f = (const float*)d_in[4];
    const float* fox_q_gain = (const float*)d_in[5];
    const float* fox_k_gain = (const float*)d_in[6];
    const float* fox_w_out = (const float*)d_in[7];
    const float* hgrn_norm = (const float*)d_in[8];
    const float* hgrn_w_in = (const float*)d_in[9];
    const float* hgrn_lb = (const float*)d_in[10];
    const float* hgrn_o_gain = (const float*)d_in[11];
    const float* hgrn_w_out = (const float*)d_in[12];
    const float* ffn_norm = (const float*)d_in[13];
    const float* ffn_w_gate = (const float*)d_in[14];
    const float* ffn_w_up = (const float*)d_in[15];
    const float* ffn_conv_w = (const float*)d_in[16];
    const float* ffn_conv_b = (const float*)d_in[17];
    const float* ffn_w_down = (const float*)d_in[18];
    float* out = (float*)d_out;

    char* ws = (char*)d_ws;
    const size_t szH = (size_t)L * D * 4;
    float* Hb = (float*)ws;
    float* XN = (float*)(ws + szH);
    float* BIG = (float*)(ws + 2 * szH);
    float* Abuf = BIG;
    float* Ubuf = BIG + (size_t)L * FF;
    float* LF = (float*)(ws + 2 * szH + (size_t)2 * L * FF * 4);
    float* Cc = LF + (size_t)H * L;

    for (int b = 0; b < NB; ++b) {
        hipLaunchKernelGGL(build_h, dim3(L), dim3(256), 0, stream, x + (size_t)b * SEQ * D, meta, Hb);
        for (int layer = 0; layer < 2; ++layer) {
            if (layer == 0) {
                hipLaunchKernelGGL(rmsnorm_rows, dim3(L), dim3(64), 0, stream, Hb, fox_norm, XN);
                gemm(XN, D, fox_w_in, NIN, BIG, NIN, nullptr, L, NIN, D, stream);
                hipLaunchKernelGGL(fox_prep, dim3(L), dim3(64), 0, stream, BIG, fox_q_gain, fox_k_gain, fox_b_f, LF);
                hipLaunchKernelGGL(cumsum_rows, dim3(H), dim3(1024), 0, stream, LF, Cc);
                hipLaunchKernelGGL(fox_attn_naive, dim3(L, H), dim3(64), 0, stream, BIG, Cc, XN);
                hipLaunchKernelGGL(fox_gate, dim3(L), dim3(256), 0, stream, XN, BIG);
                gemm(XN, D, fox_w_out, D, Hb, D, Hb, L, D, D, stream);
            } else {
                hipLaunchKernelGGL(rmsnorm_rows, dim3(L), dim3(64), 0, stream, Hb, hgrn_norm, XN);
                gemm(XN, D, hgrn_w_in, 4 * D, BIG, 4 * D, nullptr, L, 4 * D, D, stream);
                hipLaunchKernelGGL(hgrn_prep, dim3(L), dim3(256), 0, stream, BIG, hgrn_lb);
                hipLaunchKernelGGL(hgrn_rec_naive, dim3(HH * 2), dim3(64), 0, stream, BIG, XN);
                hipLaunchKernelGGL(hgrn_post, dim3(L, HH), dim3(64), 0, stream, XN, BIG, hgrn_o_gain);
                gemm(XN, D, hgrn_w_out, D, Hb, D, Hb, L, D, D, stream);
            }
            hipLaunchKernelGGL(rmsnorm_rows, dim3(L), dim3(64), 0, stream, Hb, ffn_norm + (size_t)layer * D, XN);
            gemm(XN, D, ffn_w_gate + (size_t)layer * D * FF, FF, Abuf, FF, nullptr, L, FF, D, stream);
            gemm(XN, D, ffn_w_up + (size_t)layer * D * FF, FF, Ubuf, FF, nullptr, L, FF, D, stream);
            hipLaunchKernelGGL(ffn_ew, dim3(L), dim3(256), 0, stream, Abuf, Ubuf, ffn_conv_w + (size_t)layer * 3 * FF, ffn_conv_b + (size_t)layer * FF);
            gemm(Ubuf, FF, ffn_w_down + (size_t)layer * FF * D, D, Hb, D, Hb, L, D, FF, stream);
        }
        hipLaunchKernelGGL(write_out, dim3(SEQ), dim3(256), 0, stream, Hb, out + (size_t)b * SEQ * D);
    }
}
```

```cpp
#include <hip/hip_runtime.h>
#include <hip/hip_bf16.h>
#include <cstdint>
#include <cstdio>
#include <cmath>

constexpr int NB = 2, SEQ = 8192, NMETA = 16, L = SEQ + NMETA, D = 1024, H = 16, HD = 64, FF = 2816, HH = 8, DK = 128;
constexpr int M = NB * SEQ;
constexpr int NIN = 4 * D + H;
constexpr int KVROWS = 8320, KV_META0 = 112, KV_MAIN0 = 128;
constexpr float EPS = 1e-6f;
constexpr float LOG2E = 1.4426950408889634f;
constexpr float C2 = 0.125f * LOG2E;
constexpr float BIAS_DUMMY = -1000.f;

constexpr size_t MiB = 1u << 20, KiB = 1u << 10;
constexpr size_t WS_CTL = 0, CTL_ZERO_BYTES = 1 * MiB;
constexpr size_t WS_SSQ = 1 * MiB;
constexpr size_t WS_LOGF = 2 * MiB;
constexpr size_t WS_BIAS = 3 * MiB + 256 * KiB;
constexpr size_t WS_META = 4 * MiB + 512 * KiB;
constexpr size_t MT_HMA = WS_META, MT_HMB = WS_META + 64 * KiB, MT_MW = WS_META + 128 * KiB, MT_MW2 = WS_META + 384 * KiB, MT_MWG = WS_META + 448 * KiB,
                 MT_MWU = WS_META + 624 * KiB, MT_MW3 = WS_META + 800 * KiB, MT_MA = WS_META + 864 * KiB, MT_MY = WS_META + 896 * KiB, MT_MSSQ = WS_META + 984 * KiB, MT_LB = WS_META + 992 * KiB, MT_T0 = WS_META + 996 * KiB;
constexpr size_t WS_HDEC = 5 * MiB + 512 * KiB;
constexpr size_t WS_NHM = 6 * MiB;
constexpr size_t WS_HB = 8 * MiB;
constexpr size_t WS_WG = 40 * MiB, WS_WU = WS_WG + (size_t)FF * D * 2, WS_WD = WS_WU + (size_t)FF * D * 2;
constexpr size_t WS_WIN = 57 * MiB, WS_WOUT = 65 * MiB;
constexpr size_t WS_A = 67 * MiB, WS_Y = 155 * MiB;
constexpr size_t WS_Q = 67 * MiB, WS_K = 99 * MiB, WS_V = 132 * MiB, WS_GATE = 165 * MiB;
constexpr size_t WS_QH = 67 * MiB, WS_VH = 99 * MiB, WS_G = 131 * MiB, WS_LF = 163 * MiB, WS_ST = WS_HB;
constexpr size_t WS_END = 256 * MiB;
static_assert(WS_Y + (size_t)M * FF * 2 <= WS_END && WS_WD + (size_t)FF * D * 2 <= WS_WIN && WS_LF + (size_t)M * D * 4 <= WS_END, "ws map");
static_assert(WS_VH == WS_QH + (size_t)M * D * 2 && WS_G == WS_VH + (size_t)M * D * 2, "EpiHgIn addresses QH | VH | G by offset");
static_assert(WS_K + (size_t)NB * KVROWS * D * 2 <= WS_V && WS_V + (size_t)NB * KVROWS * D * 2 <= WS_GATE, "ws map kv");

typedef unsigned short bf16_t;
namespace pg8 {
#define PG8_LAS __attribute__((address_space(3)))
typedef unsigned short bf16_t;
typedef short bf16x8 __attribute__((ext_vector_type(8)));
typedef float f32x4 __attribute__((ext_vector_type(4)));
typedef unsigned u32x4 __attribute__((ext_vector_type(4)));
constexpr int BM = 256, BK = 64, HALF = 128, HTB = HALF * BK * 2  , STAGE_BYTES = 8 * HTB, NXCD = 8, WGM = 8;

__host__ __device__ __forceinline__ int lds_byte(int r, int c) { const int st = (r >> 4) * 2 + (c >> 5), rr = r & 15, cc = c & 31, ob = rr * 64 + cc * 2; return st * 1024 + (ob ^ (((ob >> 9) & 1) << 5)); }
__host__ __device__ __forceinline__ void stage_rc(int b, int& R, int& C) { const int st = b / 1024, sb = b % 1024, swz = sb ^ (((sb >> 9) & 1) << 5); R = (st >> 1) * 16 + swz / 64; C = (st & 1) * 32 + (swz % 64) / 2; }
__host__ __device__ __forceinline__ int perm32(int rho) { const int n = rho >> 4, i = rho & 15; return 8 * (i >> 2) + 4 * n + (i & 3); }

struct Unit { int pm, pn, r0, c0, part; };
struct Gemm { const bf16_t* A; const bf16_t* Bt; int M, N, K; };

struct StaticOrder {
    int nM, nN, nwg, G, c;
    __host__ __device__ void init(int M, int N, int G_, int c_) { nM = M / BM; nN = N / BM; nwg = nM * nN; G = G_; c = c_; }
    __host__ __device__ bool next(int i, Unit& u) const {
        const long L = (long)i * G + c; if (L >= nwg) return false;
        int wgid = (int)L; { const int q = nwg / NXCD, r = nwg % NXCD, xcd = wgid % NXCD, off = wgid / NXCD; wgid = (xcd < r ? xcd * (q + 1) : r * (q + 1) + (xcd - r) * q) + off; }
        const int nig = WGM * nN, gid = wgid / nig, fm = gid * WGM, gsz = (nM - fm) < WGM ? (nM - fm) : WGM;
        u.pm = fm + ((wgid % nig) % gsz); u.pn = (wgid % nig) / gsz; u.r0 = u.pm * BM; u.c0 = u.pn * BM; u.part = 0; return true;
    }
    __device__ __forceinline__ void a_ready(const Unit&) const {}
    __device__ __forceinline__ void done(const Unit&) const {}
};

struct NoPre { __device__ __forceinline__ void operator()() const {} };
struct PartOrder : StaticOrder {
    __host__ __device__ bool next(int i, Unit& u) const {
        if (G != 256 || nM != 64 || nN != 11) return StaticOrder::next(i, u);
        if (i >= 3) return false;
        const int xcd = c & 7, off = c >> 3;
        if (i < 2) { const int o = i * 32 + off; u.pm = 8 * xcd + (o & 7); u.pn = o >> 3; u.r0 = u.pm * BM; u.c0 = u.pn * BM; u.part = 0; }
        else { u.r0 = 8 * xcd * BM + HALF * (off & 15); u.c0 = 8 * BM + 3 * HALF * (off >> 4); u.pm = u.r0 / BM; u.pn = 8; u.part = 1; }
        return true;
    }
};

__device__ __forceinline__ unsigned cvt_pk_bf16(float lo, float hi) { unsigned r; asm volatile("v_cvt_pk_bf16_f32 %0, %1, %2" : "=v"(r) : "v"(lo), "v"(hi)); return r; }
typedef float f32x2 __attribute__((ext_vector_type(2)));
template <class Epi, class Sched, bool ALIGN_EPI = false, bool SP2 = false, bool HASPART = false, class Pre = NoPre>
__device__ __forceinline__ void gemm_phase(PG8_LAS unsigned char* lds, const Gemm g, const Sched& S, const Epi& E, const int tid_in, const Pre& pre = Pre()) {
    const int tid = tid_in, wid = __builtin_amdgcn_readfirstlane(tid >> 6), lane = tid & 63, wr = wid >> 2, wc = wid & 3, fr = lane & 15, fq = lane >> 4;
    const int K = g.K, nt = K / BK;
    unsigned voffA[2], voffB[2];
#pragma unroll
    for (int i = 0; i < 2; ++i) { int R, C; stage_rc(tid * 16 + i * 8192, R, C); const int Rb = Epi::PERM ? ((R & ~31) + perm32(R & 31)) : R;
        voffA[i] = (unsigned)(R * K + C) * 2u; voffB[i] = (unsigned)(Rb * K + C) * 2u; }
    const size_t kstep = (size_t)(BK * 2);
    const size_t hstep = (size_t)HALF * K * 2;
    const size_t rstep = (size_t)K * 2;
    static_assert(SP2 || !HASPART, "part units need the two-super-phase loop");
    const unsigned ldsw = (unsigned)wid * 1024u;
    const int aoff = lds_byte(wr * 64 + fr, fq * 8), boff = lds_byte(wc * 32 + fr, fq * 8);
#define PG8_SA(b, h) (((b) * 2 + (h)) * HTB)
#define PG8_SB(b, h) ((4 + (b) * 2 + (h)) * HTB)
#define PG8_STAGE(bufoff, gbase, voff) do { _Pragma("unroll") for (int _i = 0; _i < 2; ++_i) \
        __builtin_amdgcn_global_load_lds((const unsigned*)((const char*)(gbase) + (voff)[_i]), (PG8_LAS unsigned*)(lds + (bufoff) + ldsw + _i * 8192), 16, 0, 0); } while (0)
#define PG8_LDA(dst, b, h) do { _Pragma("unroll") for (int m = 0; m < 4; ++m) _Pragma("unroll") for (int k = 0; k < 2; ++k) dst[m][k] = *(const PG8_LAS bf16x8*)(lds + PG8_SA(b, h) + aoff + m * 2048 + k * 1024); } while (0)
#define PG8_LDBX(dst, off) do { _Pragma("unroll") for (int n = 0; n < 2; ++n) _Pragma("unroll") for (int k = 0; k < 2; ++k) dst[n][k] = *(const PG8_LAS bf16x8*)(lds + (off) + boff + n * 2048 + k * 1024); } while (0)
#define PG8_LDB(dst, b, h) do { _Pragma("unroll") for (int n = 0; n < 2; ++n) _Pragma("unroll") for (int k = 0; k < 2; ++k) dst[n][k] = *(const PG8_LAS bf16x8*)(lds + PG8_SB(b, h) + boff + n * 2048 + k * 1024); } while (0)
#define PG8_MMA(ai, bj, At, Bt) do { __builtin_amdgcn_s_setprio(1); _Pragma("unroll") for (int m = 0; m < 4; ++m) _Pragma("unroll") for (int n = 0; n < 2; ++n) _Pragma("unroll") for (int k = 0; k < 2; ++k) \
        acc[ai][bj][m][n] = __builtin_amdgcn_mfma_f32_16x16x32_bf16(Bt[n][k], At[m][k], acc[ai][bj][m][n], 0, 0, 0); __builtin_amdgcn_s_setprio(0); } while (0)
#define PG8_WAIT_V(n) asm volatile("s_waitcnt vmcnt(" #n ")" ::: "memory")
#define PG8_WAIT_L(n) asm volatile("s_waitcnt lgkmcnt(" #n ")" ::: "memory")
#define PG8_BAR __builtin_amdgcn_s_barrier()
#define PG8_SCHED __builtin_amdgcn_sched_barrier(0)
    Unit cur, nxt; int ui = 0;
    if (!S.next(0, cur)) return;
    bf16x8 At[4][2], B0[2][2], B1[2][2];
    const char* cA = (const char*)g.A + (size_t)cur.r0 * rstep; const char* cB = (const char*)g.Bt + (size_t)cur.c0 * rstep;
    S.a_ready(cur);
    if constexpr (SP2) {
        PG8_STAGE(PG8_SB(0, 0), cB, voffB); PG8_STAGE(PG8_SB(0, 1), cB + hstep, voffB); PG8_STAGE(PG8_SA(0, 0), cA, voffA); PG8_STAGE(PG8_SA(0, 1), cA + hstep, voffA);
        pre();
        if (wr == 1) PG8_BAR;
        PG8_WAIT_V(2); PG8_BAR;
        PG8_STAGE(PG8_SB(1, 0), cB + kstep, voffB); PG8_STAGE(PG8_SA(1, 0), cA + kstep, voffA); PG8_STAGE(PG8_SB(1, 1), cB + hstep + kstep, voffB);
        PG8_WAIT_V(6); PG8_BAR;
    } else {
        PG8_STAGE(PG8_SB(0, 0), cB, voffB); PG8_STAGE(PG8_SA(0, 0), cA, voffA); PG8_STAGE(PG8_SB(0, 1), cB + hstep, voffB); PG8_STAGE(PG8_SA(0, 1), cA + hstep, voffA);
        if (wr == 1) PG8_BAR;
        PG8_WAIT_V(4); PG8_BAR;
        PG8_STAGE(PG8_SB(1, 0), cB + kstep, voffB); PG8_STAGE(PG8_SA(1, 0), cA + kstep, voffA); PG8_STAGE(PG8_SB(1, 1), cB + hstep + kstep, voffB);
        PG8_WAIT_V(6); PG8_BAR;
    }
    f32x4 acc[2][2][4][2];
#pragma unroll
    for (int a = 0; a < 2; ++a)
#pragma unroll
        for (int b = 0; b < 2; ++b)
#pragma unroll
            for (int m = 0; m < 4; ++m)
#pragma unroll
                for (int n = 0; n < 2; ++n) acc[a][b][m][n] = (f32x4){0.f, 0.f, 0.f, 0.f};
    for (;;) {
        const bool has_next = S.next(ui + 1, nxt);
        const char* nA = has_next ? (const char*)g.A + (size_t)nxt.r0 * rstep : cA; const char* nB = has_next ? (const char*)g.Bt + (size_t)nxt.c0 * rstep : cB;
        const bool npart = HASPART && has_next && nxt.part != 0;
        if (HASPART && cur.part) {
        for (int t = 0; t < nt; t += 2) {
            const bool last = (t == nt - 2);
            const char* b1 = cB + (size_t)(t + 1) * kstep;
            const char* a2 = last ? nA : cA + (size_t)(t + 2) * kstep; const char* b2 = last ? nB : cB + (size_t)(t + 2) * kstep;
            const char* a3 = a2 + kstep; const char* b3 = b2 + kstep;
            PG8_LDB(B0, 0, 0); PG8_LDB(B1, 0, 1); PG8_SCHED; PG8_LDA(At, 0, 0); PG8_STAGE(PG8_SA(1, 1), b1 + 2 * hstep, voffB);
            PG8_WAIT_V(8); PG8_WAIT_L(0); PG8_BAR; PG8_MMA(0, 0, At, B0); PG8_MMA(0, 1, At, B1); PG8_BAR; PG8_SCHED;
            PG8_LDBX(B0, PG8_SA(0, 1)); PG8_STAGE(PG8_SB(0, 0), b2, voffB); PG8_STAGE(PG8_SB(0, 1), b2 + hstep, voffB); PG8_STAGE(PG8_SA(0, 0), a2, voffA);
            PG8_WAIT_V(8); PG8_WAIT_L(0); PG8_BAR; PG8_MMA(1, 0, At, B0); PG8_BAR; PG8_SCHED;
            PG8_LDB(B0, 1, 0); PG8_LDB(B1, 1, 1); PG8_SCHED; PG8_LDA(At, 1, 0); PG8_STAGE(PG8_SA(0, 1), b2 + 2 * hstep, voffB);
            PG8_WAIT_V(8); PG8_WAIT_L(0); PG8_BAR; PG8_MMA(0, 0, At, B0); PG8_MMA(0, 1, At, B1); PG8_BAR; PG8_SCHED;
            PG8_LDBX(B0, PG8_SA(1, 1)); PG8_STAGE(PG8_SB(1, 0), b3, voffB); PG8_STAGE(PG8_SB(1, 1), b3 + hstep, voffB); PG8_STAGE(PG8_SA(1, 0), a3, voffA);
            PG8_WAIT_V(8); PG8_WAIT_L(0); PG8_BAR; PG8_MMA(1, 0, At, B0); PG8_BAR; PG8_SCHED;
        }
        } else
        for (int t = 0; t < nt; t += 2) {
            const bool last = (t == nt - 2);
            const char* a1 = cA + (size_t)(t + 1) * kstep;
            const char* a2 = last ? nA : cA + (size_t)(t + 2) * kstep; const char* b2 = last ? nB : cB + (size_t)(t + 2) * kstep;
            const char* a3 = a2 + kstep; const char* b3 = b2 + kstep;
            if (last && has_next) S.a_ready(nxt);
            if constexpr (SP2) {
            PG8_LDB(B0, 0, 0); PG8_LDB(B1, 0, 1); PG8_SCHED; PG8_LDA(At, 0, 0); PG8_STAGE(PG8_SA(1, 1), a1 + hstep, voffA);
            PG8_WAIT_V(8); PG8_WAIT_L(0); PG8_BAR; PG8_MMA(0, 0, At, B0); PG8_MMA(0, 1, At, B1); PG8_BAR; PG8_SCHED;
            PG8_LDA(At, 0, 1); PG8_STAGE(PG8_SB(0, 0), b2, voffB); PG8_STAGE(PG8_SB(0, 1), b2 + hstep, voffB); PG8_STAGE(PG8_SA(0, 0), a2, voffA);
            PG8_WAIT_V(8); PG8_WAIT_L(0); PG8_BAR; PG8_MMA(1, 0, At, B0); PG8_MMA(1, 1, At, B1); PG8_BAR; PG8_SCHED;
            PG8_LDB(B0, 1, 0); PG8_LDB(B1, 1, 1); PG8_SCHED; PG8_LDA(At, 1, 0);
            if constexpr (HASPART) { const bool sw = last && npart;
                const char* p01 = sw ? nB + 2 * hstep : a2 + hstep; const unsigned vo[2] = {sw ? voffB[0] : voffA[0], sw ? voffB[1] : voffA[1]}; PG8_STAGE(PG8_SA(0, 1), p01, vo); }
            else PG8_STAGE(PG8_SA(0, 1), a2 + hstep, voffA);
            PG8_WAIT_V(8); PG8_WAIT_L(0); PG8_BAR; PG8_MMA(0, 0, At, B0); PG8_MMA(0, 1, At, B1); PG8_BAR; PG8_SCHED;
            PG8_LDA(At, 1, 1); PG8_STAGE(PG8_SB(1, 0), b3, voffB); PG8_STAGE(PG8_SB(1, 1), b3 + hstep, voffB); PG8_STAGE(PG8_SA(1, 0), a3, voffA);
            PG8_WAIT_V(8); PG8_WAIT_L(0); PG8_BAR; PG8_MMA(1, 0, At, B0); PG8_MMA(1, 1, At, B1); PG8_BAR; PG8_SCHED;
            } else {
            PG8_LDB(B0, 0, 0); PG8_SCHED; PG8_LDA(At, 0, 0); PG8_STAGE(PG8_SA(1, 1), a1 + hstep, voffA);
            PG8_WAIT_L(8); PG8_BAR; PG8_WAIT_L(0); PG8_MMA(0, 0, At, B0); PG8_BAR; PG8_SCHED;
            PG8_LDB(B1, 0, 1); PG8_STAGE(PG8_SB(0, 0), b2, voffB);
            PG8_BAR; PG8_WAIT_L(0); PG8_MMA(0, 1, At, B1); PG8_BAR;
            PG8_LDA(At, 0, 1); PG8_STAGE(PG8_SA(0, 0), a2, voffA);
            PG8_BAR; PG8_WAIT_L(0); PG8_MMA(1, 0, At, B0); PG8_BAR; PG8_SCHED;
            PG8_STAGE(PG8_SB(0, 1), b2 + hstep, voffB);
            PG8_WAIT_V(6); PG8_BAR; PG8_MMA(1, 1, At, B1); PG8_BAR;
            PG8_LDB(B0, 1, 0); PG8_SCHED; PG8_LDA(At, 1, 0); PG8_STAGE(PG8_SA(0, 1), a2 + hstep, voffA);
            PG8_WAIT_L(8); PG8_BAR; PG8_WAIT_L(0); PG8_MMA(0, 0, At, B0); PG8_BAR; PG8_SCHED;
            PG8_LDB(B1, 1, 1); PG8_STAGE(PG8_SB(1, 0), b3, voffB);
            PG8_BAR; PG8_WAIT_L(0); PG8_MMA(0, 1, At, B1); PG8_BAR;
            PG8_LDA(At, 1, 1); PG8_STAGE(PG8_SA(1, 0), a3, voffA);
            PG8_BAR; PG8_WAIT_L(0); PG8_MMA(1, 0, At, B0); PG8_BAR; PG8_SCHED;
            PG8_STAGE(PG8_SB(1, 1), b3 + hstep, voffB);
            PG8_WAIT_V(6); PG8_BAR; PG8_MMA(1, 1, At, B1); PG8_BAR;
            }
        }
        if constexpr (ALIGN_EPI) { if (wr == 0) PG8_BAR; }
        if constexpr (!Epi::AFTER_DRAIN) {
            if constexpr (HASPART) { if (cur.part) E.part(acc, cur, wr, wc, fr, fq); else E(acc, cur, wr, wc, fr, fq); }
            else E(acc, cur, wr, wc, fr, fq);
            S.done(cur); }
        if (!has_next) break;
#pragma unroll
        for (int a = 0; a < 2; ++a)
#pragma unroll
            for (int b = 0; b < 2; ++b)
#pragma unroll
                for (int m = 0; m < 4; ++m)
#pragma unroll
                    for (int n = 0; n < 2; ++n) acc[a][b][m][n] = (f32x4){0.f, 0.f, 0.f, 0.f};
        cur = nxt; cA = nA; cB = nB; ++ui;
        if constexpr (ALIGN_EPI) { if (wr == 1) PG8_BAR; }
    }
    PG8_WAIT_V(0);
    if constexpr (!ALIGN_EPI) { if (wr == 0) PG8_BAR; }
    PG8_BAR;
    if constexpr (Epi::AFTER_DRAIN) { E.fused(acc, cur, wr, wc, fr, fq, lds, wid, lane); S.done(cur); }
#undef PG8_SA
#undef PG8_SB
#undef PG8_STAGE
#undef PG8_LDA
#undef PG8_LDB
#undef PG8_LDBX
#undef PG8_MMA
#undef PG8_WAIT_V
#undef PG8_WAIT_L
#undef PG8_BAR
#undef PG8_SCHED
}
}

#ifndef PG8_SP2
#define PG8_SP2 true
#endif
#ifndef PG8_ALIGN
#define PG8_ALIGN true
#endif
#define GAS __attribute__((address_space(1)))
#define LAS __attribute__((address_space(3)))
typedef unsigned short bf16;
typedef unsigned v4u __attribute__((ext_vector_type(4)));
typedef float f32x4 __attribute__((ext_vector_type(4)));
typedef short bf16x8 __attribute__((ext_vector_type(8)));
typedef GAS unsigned gu32;
typedef GAS unsigned long long gu64;
#define RLX_AGENT __ATOMIC_RELAXED, __HIP_MEMORY_SCOPE_AGENT
#define LDS_WAIT() asm volatile("s_waitcnt lgkmcnt(0)" ::: "memory")
#define VM_WAIT() asm volatile("s_waitcnt vmcnt(0)" ::: "memory")
__device__ __forceinline__ unsigned long long rt() { return __builtin_amdgcn_s_memrealtime(); }
__device__ __forceinline__ unsigned f2bf(float f) { unsigned u = __builtin_bit_cast(unsigned, f); return (u + 0x7fffu + ((u >> 16) & 1u)) >> 16; }
typedef float f32x2_hw __attribute__((ext_vector_type(2))); typedef __bf16 bf16x2_hw __attribute__((ext_vector_type(2)));
__device__ __forceinline__ unsigned pk2(float lo, float hi) { const f32x2_hw v = {lo, hi}; return __builtin_bit_cast(unsigned, __builtin_convertvector(v, bf16x2_hw)); }

#define XB_TMO      128
#define XB_XCNT(j)  (256  + 64 * (j))
#define XB_XSUB(j)  (1280 + 64 * (j))
#define XB_XGEN(j)  (2304 + 64 * (j))
#define XB_TOP      3328
#define XB_TOPGEN   3392
#define XCD_BAR_WORDS 3456
#define XB_SPIN_CAP (1u << 18)

__device__ __forceinline__ unsigned xb_ld(unsigned* p)              { return __hip_atomic_load(p, __ATOMIC_RELAXED, __HIP_MEMORY_SCOPE_AGENT); }
__device__ __forceinline__ unsigned xb_add(unsigned* p, unsigned v) { return __hip_atomic_fetch_add(p, v, __ATOMIC_RELAXED, __HIP_MEMORY_SCOPE_AGENT); }
__device__ __forceinline__ unsigned xb_xcc_id() { return (unsigned)__builtin_amdgcn_s_getreg((3 << 11) | 20) & 0xFu; }
#define XB_SPIN(cond, bar) do { unsigned _sp = 0; while (cond) { __builtin_amdgcn_s_sleep(1); \
    if ((++_sp & 255u) == 0u) { if (xb_ld(&(bar)[XB_TMO])) break; if (_sp > XB_SPIN_CAP) { atomicAdd(&(bar)[XB_TMO], 1u); break; } } } } while (0)

struct XcdBarrier {
    unsigned* bar; unsigned x;
    volatile LAS unsigned* st;
};

__device__ __forceinline__ XcdBarrier xcd_barrier_post(unsigned* bar, volatile LAS unsigned* st, const bool leader) {
    XcdBarrier b; b.bar = bar; b.x = xb_xcc_id(); b.st = st;
    if (leader) (void)xb_add(&bar[XB_XCNT(b.x)], 1u);
    return b;
}
__device__ __forceinline__ void xcd_barrier_complete(unsigned* bar, unsigned x, unsigned& nloc, unsigned& nx) {
    const unsigned G = gridDim.x * gridDim.y * gridDim.z;
    unsigned sum, cnt, mine, sp = 0u;
    for (;;) {
        sum = 0u; cnt = 0u; mine = 0u;
#pragma unroll
        for (unsigned j = 0; j < 16; ++j) { const unsigned c = xb_ld(&bar[XB_XCNT(j)]); sum += c; cnt += (c > 0u) ? 1u : 0u; mine = (j == x) ? c : mine; }
        if (sum == G) break;
        __builtin_amdgcn_s_sleep(1);
        if ((++sp & 255u) == 0u) { if (xb_ld(&bar[XB_TMO])) break; if (sp > XB_SPIN_CAP) { atomicAdd(&bar[XB_TMO], 1u); break; } }
    }
    nloc = mine > 0u ? mine : 1u; nx = cnt > 0u ? cnt : 1u;
}

__device__ __forceinline__ void xcd_barrier(const XcdBarrier& b, const bool leader) {
    asm volatile("s_waitcnt vmcnt(0)" ::: "memory");
    __syncthreads();
    if (leader) {
        unsigned* bar = b.bar;
        __builtin_amdgcn_s_waitcnt(0);
        unsigned nloc = b.st[0], nx = b.st[1];
        if (nloc == 0u) { xcd_barrier_complete(bar, b.x, nloc, nx); b.st[0] = nloc; b.st[1] = nx; }
        const unsigned old = xb_add(&bar[XB_XSUB(b.x)], 1u);
        const unsigned gen = old / nloc;
        if (old + 1u == (gen + 1u) * nloc) {
            __builtin_amdgcn_fence(__ATOMIC_RELEASE, "agent");
            asm volatile("s_waitcnt vmcnt(0)" ::: "memory");
            const unsigned og = xb_add(&bar[XB_TOP], 1u);
            const unsigned tg = og / nx;
            if (og + 1u == (tg + 1u) * nx) xb_add(&bar[XB_TOPGEN], 1u);
            else XB_SPIN(xb_ld(&bar[XB_TOPGEN]) == tg, bar);
            __builtin_amdgcn_fence(__ATOMIC_ACQUIRE, "agent");
            xb_add(&bar[XB_XGEN(b.x)], 1u);
            asm volatile("s_waitcnt vmcnt(0)" ::: "memory");
        } else {
            XB_SPIN(xb_ld(&bar[XB_XGEN(b.x)]) == gen, bar);
            __builtin_amdgcn_fence(__ATOMIC_ACQUIRE, "agent");
            asm volatile("s_waitcnt vmcnt(0)" ::: "memory");
        }
    }
    __syncthreads();
}


constexpr int NWAVES = 8, NTHREADS = 512;
constexpr int RING_BYTES = 131072, LDSCTL_OFF = RING_BYTES, MISC_OFF = LDSCTL_OFF + 320, LDS_BYTES = 147456;
typedef unsigned v2u __attribute__((ext_vector_type(2)));
typedef float f32x16 __attribute__((ext_vector_type(16)));

#define DPP_MOV(v, ctrl) __int_as_float(__builtin_amdgcn_update_dpp(0, __float_as_int(v), (ctrl), 0xf, 0xf, false))
__device__ __forceinline__ float row16_sum(float v) { v += DPP_MOV(v, 0xB1); v += DPP_MOV(v, 0x4E); v += DPP_MOV(v, 0x141); v += DPP_MOV(v, 0x140); return v; }
__device__ __forceinline__ float row16_max(float v) { v = fmaxf(v, DPP_MOV(v, 0xB1)); v = fmaxf(v, DPP_MOV(v, 0x4E)); v = fmaxf(v, DPP_MOV(v, 0x141)); v = fmaxf(v, DPP_MOV(v, 0x140)); return v; }
__device__ __forceinline__ float wave_sum(float v) { v = row16_sum(v); v += __shfl_xor(v, 16); v += __shfl_xor(v, 32); return v; }
__device__ __forceinline__ float wave_max(float v) { v = row16_max(v); v = fmaxf(v, __shfl_xor(v, 16)); v = fmaxf(v, __shfl_xor(v, 32)); return v; }
__device__ __forceinline__ float sigm(float x) { return __builtin_amdgcn_rcpf(1.f + __builtin_amdgcn_exp2f(x * -LOG2E)); }
__device__ __forceinline__ float bf2f(unsigned short b) { return __uint_as_float((unsigned)b << 16); }
__device__ __forceinline__ void unpack8(const v4u w, float* o) {
    o[0] = __uint_as_float(w.x << 16); o[1] = __uint_as_float(w.x & 0xffff0000u); o[2] = __uint_as_float(w.y << 16); o[3] = __uint_as_float(w.y & 0xffff0000u);
    o[4] = __uint_as_float(w.z << 16); o[5] = __uint_as_float(w.z & 0xffff0000u); o[6] = __uint_as_float(w.w << 16); o[7] = __uint_as_float(w.w & 0xffff0000u);
}
__device__ __forceinline__ v4u pack8(const float* v) { v4u w; w.x = pk2(v[0], v[1]); w.y = pk2(v[2], v[3]); w.z = pk2(v[4], v[5]); w.w = pk2(v[6], v[7]); return w; }
__device__ __forceinline__ float rstd_from_parts(const float* ssq, int row) {
    const f32x4* p = (const f32x4*)(ssq + (size_t)row * 16); const f32x4 a = (p[0] + p[1]) + (p[2] + p[3]);
    return rsqrtf(((a.x + a.y) + (a.z + a.w)) * (1.f / D) + EPS);
}
__device__ __forceinline__ float rstd_quad(const float* __restrict__ ssq, int row, int fq) {
    const f32x4 a = *((const f32x4*)(ssq + (size_t)row * 16) + fq); float s = (a.x + a.y) + (a.z + a.w);
    s += __shfl_xor(s, 16); s += __shfl_xor(s, 32);
    return rsqrtf(s * (1.f / D) + EPS);
}

struct Frame { LAS unsigned char* lds; int tid, lane, wave, G, bid; unsigned char* ws;
    __device__ __forceinline__ void refresh() { int l; asm volatile("v_mbcnt_lo_u32_b32 %0, -1, 0\n\tv_mbcnt_hi_u32_b32 %0, -1, %0" : "=v"(l)); lane = l; tid = wave * 64 + l; } };

__device__ __forceinline__ void conv_item(const float* __restrict__ W, int ldw, int K, bf16_t* __restrict__ WT, int n_st0, int src0, int k0, const float* __restrict__ gain, LAS float* scr, int lane) {
    f32x4 wv[8];
#pragma unroll
    for (int i = 0; i < 8; ++i) wv[i] = *(const f32x4*)(W + (size_t)(k0 + 8 * i + (lane >> 3)) * ldw + src0 + 4 * (lane & 7));
    if (gain) {
#pragma unroll
        for (int i = 0; i < 8; ++i) wv[i] = wv[i] * gain[k0 + 8 * i + (lane >> 3)]; }
#pragma unroll
    for (int i = 0; i < 8; ++i) { LAS float* d = scr + (8 * i + (lane >> 3)) * 33 + 4 * (lane & 7); d[0] = wv[i].x; d[1] = wv[i].y; d[2] = wv[i].z; d[3] = wv[i].w; }
    LDS_WAIT(); asm volatile("" ::: "memory");
    const int c = lane & 7;
#pragma unroll
    for (int j = 0; j < 4; ++j) { const int n = (lane >> 3) + 8 * j; const LAS float* s = scr + (8 * c) * 33 + n;
        v4u o; o.x = pk2(s[0 * 33], s[1 * 33]); o.y = pk2(s[2 * 33], s[3 * 33]); o.z = pk2(s[4 * 33], s[5 * 33]); o.w = pk2(s[6 * 33], s[7 * 33]);
        *(GAS v4u*)(WT + (size_t)(n_st0 + n) * K + k0 + 8 * c) = o; }
    LDS_WAIT(); asm volatile("" ::: "memory");
}
template <int MAP> __device__ __forceinline__ void conv_matrix(Frame& F, const float* W, int ldw, int K, int Nst, bf16_t* WT, const float* gain, int gw, int ngw) {
    LAS float* scr = (LAS float*)(F.lds + F.wave * 16384);
    const int nblk = Nst / 32, nitems = (K / 64) * nblk;
    for (int it = gw; it < nitems; it += ngw) {
        const int kb = it / nblk, nb = it % nblk, n_st0 = 32 * nb; int src0 = n_st0;
        if (MAP == 1) { const int pn = n_st0 >> 8, c = n_st0 & 255, bj = c >> 7, wcg = (c & 127) >> 5; const int n = 256 * pn + 64 * wcg + 32 * bj; src0 = n + ((n >= 3 * D) ? H : 0); }
        conv_item(W, ldw, K, WT, n_st0, src0, 64 * kb, gain, scr, F.lane);
    }
}
__device__ __forceinline__ float row_to_bf16(const float* xrow, bf16_t* orow, float* ssqrow, int lane) {
    const GAS f32x4* xr = (const GAS f32x4*)xrow + lane;
    f32x4 v[4]; float s = 0.f;
#pragma unroll
    for (int j = 0; j < 4; ++j) { v[j] = xr[64 * j]; s += (v[j].x * v[j].x + v[j].y * v[j].y) + (v[j].z * v[j].z + v[j].w * v[j].w); }
    s = wave_sum(s);
    GAS unsigned long long* o8 = (GAS unsigned long long*)orow + lane;
#pragma unroll
    for (int j = 0; j < 4; ++j) o8[64 * j] = (unsigned long long)pk2(v[j].x, v[j].y) | ((unsigned long long)pk2(v[j].z, v[j].w) << 32);
    if (ssqrow && lane < 4) ((f32x4*)ssqrow)[lane] = (lane == 0) ? (f32x4){s, 0.f, 0.f, 0.f} : (f32x4){0.f, 0.f, 0.f, 0.f};
    return s;
}

template <bool ABF16> __device__ __forceinline__ void side_gemm(const void* A1, const float* A2, const bf16_t* Wt, int N, int K, float* out, int gw, int ngw, int lane) {
    const int fr = lane & 15, fq = lane >> 4;
    for (int tile = gw; tile < N / 16; tile += ngw) {
        f32x4 acc = (f32x4){0.f, 0.f, 0.f, 0.f};
        const bf16_t* wrow = Wt + (size_t)(tile * 16 + fr) * K + 8 * fq;
#pragma unroll 8
        for (int k0 = 0; k0 < K; k0 += 32) {
            const bf16x8 b = *(const bf16x8*)(wrow + k0);
            bf16x8 a;
            if (ABF16) a = *(const bf16x8*)((const bf16_t*)A1 + (size_t)fr * K + k0 + 8 * fq);
            else {
                const float* p = (const float*)A1 + (size_t)fr * K + k0 + 8 * fq;
                f32x4 x0 = *(const f32x4*)p, x1 = *(const f32x4*)(p + 4);
                if (A2) { const float* q = A2 + (size_t)fr * K + k0 + 8 * fq; x0 += *(const f32x4*)q; x1 += *(const f32x4*)(q + 4); }
                const v4u w = (v4u){pk2(x0.x, x0.y), pk2(x0.z, x0.w), pk2(x1.x, x1.y), pk2(x1.z, x1.w)};
                a = __builtin_bit_cast(bf16x8, w);
            }
            acc = __builtin_amdgcn_mfma_f32_16x16x32_bf16(a, b, acc, 0, 0, 0);
        }
#pragma unroll
        for (int e = 0; e < 4; ++e) out[(size_t)(4 * fq + e) * N + tile * 16 + fr] = acc[e];
    }
}
__device__ __forceinline__ void meta_consolidate(const float* X1, const float* X2, float* dst, float* mssq, int wave, int lane) {
#pragma unroll
    for (int rr = 0; rr < 2; ++rr) {
        const int m = wave * 2 + rr; float s = 0.f;
#pragma unroll
        for (int j = 0; j < 4; ++j) { const int c = 4 * lane + 256 * j; f32x4 v = *(const f32x4*)(X1 + (size_t)m * D + c); if (X2) v += *(const f32x4*)(X2 + (size_t)m * D + c);
            if (dst) *(f32x4*)(dst + (size_t)m * D + c) = v; s += (v.x * v.x + v.y * v.y) + (v.z * v.z + v.w * v.w); }
        s = wave_sum(s);
        if (lane == 0) mssq[m] = s;
    }
}


struct ReverseOrder {
    pg8::StaticOrder B; int R;
    __host__ __device__ void init(int M_, int N_, int G_, int c_) { B.init(M_, N_, G_, c_); R = 0; pg8::Unit t; while (B.next(R, t)) ++R; }
    __host__ __device__ bool next(int i, pg8::Unit& u) const { if (i >= R) return false; return B.next(R - 1 - i, u); }
    __device__ __forceinline__ void a_ready(const pg8::Unit&) const {}
    __device__ __forceinline__ void done(const pg8::Unit&) const {}
};
using pg8::Unit;
struct EpiGate {
    static constexpr int EID = 0;
    static constexpr bool PERM = true, AFTER_DRAIN = false;
    bf16_t* __restrict__ A; const float* __restrict__ ssq;
    __device__ __forceinline__ void operator()(const f32x4 (&acc)[2][2][4][2], const Unit& u, int wr, int wc, int fr, int fq) const {
        const int row0 = u.pm * 256 + wr * 64 + fr, col0 = u.pn * 256 + wc * 32 + 8 * fq;
        float rsv[2][4];
#pragma unroll
        for (int ai = 0; ai < 2; ++ai)
#pragma unroll
            for (int m = 0; m < 4; ++m) rsv[ai][m] = rstd_quad(ssq, row0 + ai * 128 + m * 16, fq);
#pragma unroll
        for (int ai = 0; ai < 2; ++ai)
#pragma unroll
            for (int m = 0; m < 4; ++m) {
                const int row = row0 + ai * 128 + m * 16; const float rs = rsv[ai][m];
                bf16_t* rowp = A + (size_t)row * FF + col0;
#pragma unroll
                for (int bj = 0; bj < 2; ++bj) { const f32x4 v0 = acc[ai][bj][m][0] * rs, v1 = acc[ai][bj][m][1] * rs;
                    v4u w; w.x = pk2(v0[0], v0[1]); w.y = pk2(v0[2], v0[3]); w.z = pk2(v1[0], v1[1]); w.w = pk2(v1[2], v1[3]);
                    *(v4u*)(rowp + bj * 128) = w; }
            }
    }
    __device__ __forceinline__ void part(const f32x4 (&acc)[2][2][4][2], const Unit& u, int wr, int wc, int fr, int fq) const {
        const int row0 = u.r0 + wr * 64 + fr, col0 = u.c0 + wc * 32 + 8 * fq;
        float rsv[4];
#pragma unroll
        for (int m = 0; m < 4; ++m) rsv[m] = rstd_quad(ssq, row0 + m * 16, fq);
#pragma unroll
        for (int m = 0; m < 4; ++m) {
            const float rs = rsv[m]; bf16_t* rowp = A + (size_t)(row0 + m * 16) * FF + col0;
#pragma unroll
            for (int h = 0; h < 3; ++h) { const f32x4 v0 = acc[h >> 1][h & 1][m][0] * rs, v1 = acc[h >> 1][h & 1][m][1] * rs;
                v4u w; w.x = pk2(v0[0], v0[1]); w.y = pk2(v0[2], v0[3]); w.z = pk2(v1[0], v1[1]); w.w = pk2(v1[2], v1[3]);
                *(v4u*)(rowp + h * 128) = w; }
        }
    }
};
struct EpiUp {
    static constexpr int EID = 1;
    static constexpr bool PERM = true, AFTER_DRAIN = false;
    const bf16_t* __restrict__ A; bf16_t* __restrict__ Y; const float* __restrict__ ssq; const float* __restrict__ cw; const float* __restrict__ cb; const float* __restrict__ mwg; const float* __restrict__ mssq;
    static __device__ __forceinline__ unsigned shr1(unsigned prevgrp, unsigned cur) { const int t = __builtin_amdgcn_update_dpp(0, (int)prevgrp, 0x121, 0xf, 0xf, false); return (unsigned)__builtin_amdgcn_update_dpp(t, (int)cur, 0x111, 0xf, 0xf, false); }
    static __device__ __forceinline__ unsigned shr2(unsigned prevgrp, unsigned cur) { const int t = __builtin_amdgcn_update_dpp(0, (int)prevgrp, 0x122, 0xf, 0xf, false); return (unsigned)__builtin_amdgcn_update_dpp(t, (int)cur, 0x112, 0xf, 0xf, false); }
    __device__ __forceinline__ void slab(const f32x4 (&aq)[4][2], const int rtop, const int c, const float (&rsv)[4], const int fr) const {
        const int rh = rtop - 16, ih = (rtop & (SEQ - 1)) - 16;
        v4u cur[4], hal;
#pragma unroll
        for (int m = 0; m < 4; ++m) cur[m] = *(const v4u*)(A + (size_t)(rtop + m * 16) * FF + c);
        if (ih >= 0) hal = *(const v4u*)(A + (size_t)(fr >= 14 ? rh : rtop) * FF + c);
        else {
            hal = (v4u){0u, 0u, 0u, 0u};
            if (fr >= 14) { const int mm = NMETA + ih; const float mr = rsqrtf(mssq[mm] * (1.f / D) + EPS); float t[8];
#pragma unroll
                for (int e = 0; e < 8; ++e) t[e] = mr * mwg[(size_t)mm * FF + c + e];
                hal = pack8(t); }
        }
        f32x4 w0[2], w1[2], w2[2], bb[2];
#pragma unroll
        for (int q = 0; q < 2; ++q) { w0[q] = *(const f32x4*)(cw + c + 4 * q); w1[q] = *(const f32x4*)(cw + FF + c + 4 * q); w2[q] = *(const f32x4*)(cw + 2 * FF + c + 4 * q); bb[q] = *(const f32x4*)(cb + c + 4 * q); }
#pragma unroll
        for (int m = 0; m < 4; ++m) {
            const int row = rtop + m * 16; const float rs = rsv[m];
            v4u yo;
#pragma unroll
            for (int q = 0; q < 2; ++q) {
                unsigned p1[2], p2[2];
#pragma unroll
                for (int e = 0; e < 2; ++e) { const int dw = 2 * q + e; const unsigned pg = m == 0 ? hal[dw] : cur[m - 1][dw]; p1[e] = shr1(pg, cur[m][dw]); p2[e] = shr2(pg, cur[m][dw]); }
                float y[4];
#pragma unroll
                for (int e = 0; e < 4; ++e) {
                    const int dw = e >> 1; const bool hi16 = e & 1; const unsigned cu = cur[m][2 * q + dw];
                    const float ac = hi16 ? __uint_as_float(cu & 0xffff0000u) : __uint_as_float(cu << 16);
                    const float a1 = hi16 ? __uint_as_float(p1[dw] & 0xffff0000u) : __uint_as_float(p1[dw] << 16);
                    const float a2 = hi16 ? __uint_as_float(p2[dw] & 0xffff0000u) : __uint_as_float(p2[dw] << 16);
                    const float z = bb[q][e] + w0[q][e] * a2 + w1[q][e] * a1 + w2[q][e] * ac; const float uu = aq[m][q][e] * rs; y[e] = z * sigm(z) * uu;
                }
                yo[2 * q] = pk2(y[0], y[1]); yo[2 * q + 1] = pk2(y[2], y[3]);
            }
            *(v4u*)(Y + (size_t)row * FF + c) = yo;
        }
    }
    __device__ __forceinline__ void operator()(const f32x4 (&acc)[2][2][4][2], const Unit& u, int wr, int wc, int fr, int fq) const {
        const int row0 = u.pm * 256 + wr * 64 + fr, col0 = u.pn * 256 + wc * 32 + 8 * fq;
#pragma unroll
        for (int ai = 0; ai < 2; ++ai) {
            const int rtop = row0 + ai * 128;
            float rsv[4];
#pragma unroll
            for (int m = 0; m < 4; ++m) rsv[m] = rstd_quad(ssq, rtop + m * 16, fq);
#pragma unroll
            for (int bj = 0; bj < 2; ++bj) slab(acc[ai][bj], rtop, col0 + bj * 128, rsv, fr);
        }
    }
    __device__ __forceinline__ void part(const f32x4 (&acc)[2][2][4][2], const Unit& u, int wr, int wc, int fr, int fq) const {
        const int rtop = u.r0 + wr * 64 + fr, col0 = u.c0 + wc * 32 + 8 * fq;
        float rsv[4];
#pragma unroll
        for (int m = 0; m < 4; ++m) rsv[m] = rstd_quad(ssq, rtop + m * 16, fq);
#pragma unroll
        for (int h = 0; h < 3; ++h) slab(acc[h >> 1][h & 1], rtop, col0 + h * 128, rsv, fr);
    }
};
struct EpiRes {
    static constexpr int EID = 2;
    static constexpr bool PERM = true, AFTER_DRAIN = false;
    const float* basef; float* outf; bf16_t* hb; float* __restrict__ ssq;
    __device__ __forceinline__ void operator()(const f32x4 (&acc)[2][2][4][2], const Unit& u, int wr, int wc, int fr, int fq) const {
        const int row0 = u.pm * 256 + wr * 64 + fr, col0 = u.pn * 256 + wc * 32 + 8 * fq;
#pragma unroll
        for (int ai = 0; ai < 2; ++ai) {
            f32x4 bs[4][2][2];
#pragma unroll
            for (int m = 0; m < 4; ++m)
#pragma unroll
                for (int bj = 0; bj < 2; ++bj) { const size_t o = (size_t)(row0 + ai * 128 + m * 16) * D + col0 + bj * 128;
                    if (basef) { bs[m][bj][0] = *(const f32x4*)(basef + o); bs[m][bj][1] = *(const f32x4*)(basef + o + 4); }
                    else { const v4u w = *(const v4u*)(hb + o);
                        bs[m][bj][0] = (f32x4){__uint_as_float(w.x << 16), __uint_as_float(w.x & 0xffff0000u), __uint_as_float(w.y << 16), __uint_as_float(w.y & 0xffff0000u)};
                        bs[m][bj][1] = (f32x4){__uint_as_float(w.z << 16), __uint_as_float(w.z & 0xffff0000u), __uint_as_float(w.w << 16), __uint_as_float(w.w & 0xffff0000u)}; } }
            asm volatile("" ::: "memory");
#pragma unroll
            for (int m = 0; m < 4; ++m) {
                const int row = row0 + ai * 128 + m * 16; const size_t off = (size_t)row * D + col0; float s = 0.f;
#pragma unroll
                for (int bj = 0; bj < 2; ++bj) { const size_t o = off + bj * 128; const f32x4 v0 = acc[ai][bj][m][0] + bs[m][bj][0], v1 = acc[ai][bj][m][1] + bs[m][bj][1];
                    s += ((v0.x * v0.x + v0.y * v0.y) + (v0.z * v0.z + v0.w * v0.w)) + ((v1.x * v1.x + v1.y * v1.y) + (v1.z * v1.z + v1.w * v1.w));
                    if (outf) { *(f32x4*)(outf + o) = v0; *(f32x4*)(outf + o + 4) = v1; }
                    else { v4u w; w.x = pk2(v0.x, v0.y); w.y = pk2(v0.z, v0.w); w.z = pk2(v1.x, v1.y); w.w = pk2(v1.z, v1.w); *(v4u*)(hb + o) = w; } }
                if (ssq) { s += __shfl_xor(s, 16); s += __shfl_xor(s, 32); if (fq == 0) ssq[(size_t)row * 16 + u.pn * 4 + wc] = s; }
            }
            asm volatile("" ::: "memory");
        }
    }
};
struct EpiFoxIn {
    static constexpr int EID = 3;
    static constexpr bool PERM = true, AFTER_DRAIN = false;
    bf16_t *Q, *K, *V, *GT; const float* __restrict__ ssq; const float* __restrict__ gq; const float* __restrict__ gk;
    __device__ __forceinline__ void operator()(const f32x4 (&acc)[2][2][4][2], const Unit& u, int wr, int wc, int fr, int fq) const {
        const int sec = u.pn >> 2, h = 4 * (u.pn & 3) + wc, row0 = u.pm * 256 + wr * 64 + fr;
        float rsv[2][4];
#pragma unroll
        for (int ai = 0; ai < 2; ++ai)
#pragma unroll
            for (int m = 0; m < 4; ++m) rsv[ai][m] = rstd_quad(ssq, row0 + ai * 128 + m * 16, fq);
        float gg[2][8];
        if (sec < 2) { const float* g = sec == 0 ? gq : gk;
#pragma unroll
            for (int bj = 0; bj < 2; ++bj)
#pragma unroll
                for (int e = 0; e < 8; ++e) gg[bj][e] = g[32 * bj + 8 * fq + e]; }
#pragma unroll
        for (int ai = 0; ai < 2; ++ai)
#pragma unroll
            for (int m = 0; m < 4; ++m) {
                const int row = row0 + ai * 128 + m * 16; const float rs = rsv[ai][m];
                const int b = row >> 13, i = row & (SEQ - 1); const size_t kvrow = (size_t)b * KVROWS + KV_MAIN0 + i;
                float x[2][8];
#pragma unroll
                for (int bj = 0; bj < 2; ++bj)
#pragma unroll
                    for (int e = 0; e < 8; ++e) x[bj][e] = acc[ai][bj][m][e >> 2][e & 3] * rs;
                if (sec < 2) {
                    float ss = 0.f;
#pragma unroll
                    for (int bj = 0; bj < 2; ++bj)
#pragma unroll
                        for (int e = 0; e < 8; ++e) ss += x[bj][e] * x[bj][e];
                    ss += __shfl_xor(ss, 16); ss += __shfl_xor(ss, 32);
                    const float hr = rsqrtf(ss * (1.f / HD) + EPS) * (sec == 0 ? C2 : 1.f);
#pragma unroll
                    for (int bj = 0; bj < 2; ++bj)
#pragma unroll
                        for (int e = 0; e < 8; ++e) x[bj][e] *= hr * gg[bj][e];
                } else if (sec == 3) {
#pragma unroll
                    for (int bj = 0; bj < 2; ++bj)
#pragma unroll
                        for (int e = 0; e < 8; ++e) x[bj][e] = sigm(x[bj][e]);
                }
                bf16_t* dst = sec == 0 ? Q + (size_t)row * D : sec == 1 ? K + kvrow * D : sec == 2 ? V + kvrow * D : GT + (size_t)row * D;
                dst += h * HD + 8 * fq;
#pragma unroll
                for (int bj = 0; bj < 2; ++bj) *(v4u*)(dst + 32 * bj) = pack8(x[bj]);
            }
    }
};
__device__ __forceinline__ void row_load4(const float* xrow, f32x4 (&v)[4], int lane) {
    const GAS f32x4* xr = (const GAS f32x4*)xrow + 2 * lane;
#pragma unroll
    for (int j = 0; j < 4; ++j) v[j] = xr[128 * (j >> 1) + (j & 1)];
}
__device__ __forceinline__ void row_pass_fl(const f32x4 (&v)[4], bf16_t* orow, float* ssqrow, float* f32copy, float* mssq1, const LAS f32x4* wfl, const float* bfv, float* lf0, float* lf1, int lane) {
    typedef float f32x2v __attribute__((ext_vector_type(2)));
    float s = 0.f;
#pragma unroll
    for (int j = 0; j < 4; ++j) s += (v[j].x * v[j].x + v[j].y * v[j].y) + (v[j].z * v[j].z + v[j].w * v[j].w);
    s = wave_sum(s);
    if (orow) {
#pragma unroll
        for (int jj = 0; jj < 2; ++jj) { const f32x4 a = v[2 * jj], b = v[2 * jj + 1];
            ((GAS v4u*)orow)[64 * jj + lane] = (v4u){pk2(a.x, a.y), pk2(a.z, a.w), pk2(b.x, b.y), pk2(b.z, b.w)}; } }
    if (ssqrow && lane < 4) ((f32x4*)ssqrow)[lane] = (lane == 0) ? (f32x4){s, 0.f, 0.f, 0.f} : (f32x4){0.f, 0.f, 0.f, 0.f};
    if (f32copy) {
#pragma unroll
        for (int j = 0; j < 4; ++j) ((f32x4*)f32copy)[128 * (j >> 1) + 2 * lane + (j & 1)] = v[j]; }
    if (mssq1 && lane == 0) *mssq1 = s;
    const float rstd = rsqrtf(s * (1.f / D) + EPS);
    float mine = 0.f;
#pragma unroll
    for (int h = 0; h < H; ++h) {
        f32x2v a2 = (f32x2v){0.f, 0.f};
#pragma unroll
        for (int j = 0; j < 4; ++j) { const f32x4 w = wfl[h * 256 + 64 * j + lane];
            a2 = (f32x2v){v[j].x, v[j].y} * (f32x2v){w.x, w.y} + a2; a2 = (f32x2v){v[j].z, v[j].w} * (f32x2v){w.z, w.w} + a2; }
        const float a = row16_sum(a2.x + a2.y);
        mine = ((lane & 15) == h) ? a : mine;
    }
    mine += __shfl_xor(mine, 16); mine += __shfl_xor(mine, 32);
    if (lane < H) { const float xx = mine * rstd + bfv[lane]; const float lf = fminf(xx, 0.f) - log1pf(__expf(-fabsf(xx))); *lf0 = lf; if (lf1) *lf1 = lf; }
}
struct EpiHgIn {
    static constexpr int EID = 4;
    static constexpr bool PERM = true, AFTER_DRAIN = false;
    bf16_t *QH, *VH, *G; _Float16* LF; const float* __restrict__ ssq; const float* __restrict__ lbt;
    __device__ __forceinline__ void operator()(const f32x4 (&acc)[2][2][4][2], const Unit& u, int wr, int wc, int fr, int fq) const {
        const int sec = u.pn >> 2, row0 = u.pm * 256 + wr * 64 + fr, col0 = (u.pn & 3) * 256 + wc * 32 + 8 * fq;
        float rsv[2][4];
#pragma unroll
        for (int ai = 0; ai < 2; ++ai)
#pragma unroll
            for (int m = 0; m < 4; ++m) rsv[ai][m] = rstd_quad(ssq, row0 + ai * 128 + m * 16, fq);
        if (sec == 1) {
#pragma unroll
            for (int bj = 0; bj < 2; ++bj) {
                const f32x4 l0 = *(const f32x4*)(lbt + col0 + bj * 128), l1 = *(const f32x4*)(lbt + col0 + bj * 128 + 4);
#pragma unroll
                for (int ai = 0; ai < 2; ++ai)
#pragma unroll
                    for (int m = 0; m < 4; ++m) {
                        const int row = row0 + ai * 128 + m * 16; const float rs = rsv[ai][m];
                        _Float16* o = LF + (size_t)row * D + col0 + bj * 128;
                        typedef _Float16 h8_t __attribute__((ext_vector_type(8)));
                        h8_t y;
#pragma unroll
                        for (int e = 0; e < 4; ++e) { y[e] = (_Float16)__logf(l0[e] + (1.f - l0[e]) * sigm(acc[ai][bj][m][0][e] * rs)); y[4 + e] = (_Float16)__logf(l1[e] + (1.f - l1[e]) * sigm(acc[ai][bj][m][1][e] * rs)); }
                        *(h8_t*)o = y;
                        asm volatile("" ::: "memory");
                    }
            }
        } else {
            bf16_t* dst = QH + (size_t)(sec == 0 ? 0 : sec - 1) * ((size_t)M * D);
#pragma unroll
            for (int ai = 0; ai < 2; ++ai)
#pragma unroll
                for (int m = 0; m < 4; ++m) {
                    const int row = row0 + ai * 128 + m * 16; const float rs = rsv[ai][m];
#pragma unroll
                    for (int bj = 0; bj < 2; ++bj) {
                        float x[8];
#pragma unroll
                        for (int e = 0; e < 8; ++e) { const float v = acc[ai][bj][m][e >> 2][e & 3] * rs; x[e] = sec == 0 ? v * sigm(v) : sec == 3 ? sigm(v) : v; }
                        *(v4u*)(dst + (size_t)row * D + col0 + bj * 128) = pack8(x);
                    }
                    asm volatile("" ::: "memory");
                }
        }
    }
};
#include <hip/hip_bf16.h>
#include <cmath>
namespace attn_body {
using bf16=__hip_bfloat16;
using bf16x8=__attribute__((ext_vector_type(8)))short;
using s16x4=__attribute__((ext_vector_type(4)))short;
using f32x16=__attribute__((ext_vector_type(16)))float;
using u32x4=__attribute__((ext_vector_type(4)))unsigned;
constexpr int BATCH=2,NHEAD=16,SEQ=8192,KVR=8320,D=64,DM=NHEAD*D;
constexpr int NW=8,QBLK=32,QB=QBLK*NW,KVBLK=64,NQB=SEQ/QB;
constexpr int ATTN_PITCH=DM, ATTN_UNIT_ROWS=QB;
__device__ __forceinline__ int crow(int r,int hi){return (r&3)+8*(r>>2)+4*hi;}
#define SBAR() __builtin_amdgcn_sched_barrier(0)
__device__ __forceinline__ void cmask(f32x16&p0,f32x16&p1,int jb,int qrel,int hi){
  const float NEG=-INFINITY; int kb=64*jb+4*hi;
  #pragma unroll
  for(int r=0;r<16;++r){int kv=kb+(r&3)+8*(r>>2); if(kv>qrel)p0[r]=NEG; if(kv+32>qrel)p1[r]=NEG;}
}

constexpr int NSLOT=3, SLOTB=8192;
constexpr int LDS_K=0, LDS_V=NSLOT*SLOTB, LDS_WS=2*NSLOT*SLOTB, LDS_OST=LDS_WS+NW*64*4, LDS_BYTES=LDS_OST+NW*4096;
constexpr float C2=0.125f*1.4426950408889634f;
__device__ __forceinline__ void glds16(const void*gsrc,unsigned lds_dst){unsigned keep;
  asm volatile("s_mov_b32 %0, m0\n\ts_mov_b32 m0, %2\n\ts_nop 0\n\tglobal_load_lds_dwordx4 %1, off\n\ts_mov_b32 m0, %0":"=&s"(keep):"v"(gsrc),"s"(lds_dst):"memory");}
__device__ __forceinline__ float max3f(float a,float b,float c){float r;asm("v_max3_f32 %0, %1, %2, %3":"=v"(r):"v"(a),"v"(b),"v"(c));return r;}
__device__ __forceinline__ float max2f(float a,float b){float r;asm("v_max_f32_e32 %0, %1, %2":"=v"(r):"v"(a),"v"(b));return r;}
__device__ __forceinline__ float fadd_s(float a,float b){float r;asm("v_add_f32_e32 %0, %1, %2":"=v"(r):"v"(a),"v"(b));return r;}
__device__ __forceinline__ float fsub_s(float a,float b){float r;asm("v_sub_f32_e32 %0, %1, %2":"=v"(r):"v"(a),"v"(b));return r;}
typedef float f32x2_t __attribute__((ext_vector_type(2))); typedef __bf16 bf16x2_t __attribute__((ext_vector_type(2)));
__device__ __forceinline__ unsigned cvtpk_s(float lo,float hi){f32x2_t v={lo,hi};bf16x2_t b=__builtin_convertvector(v,bf16x2_t);return __builtin_bit_cast(unsigned,b);}
#define WAIT_BAR(N) asm volatile("s_waitcnt vmcnt(" #N ") lgkmcnt(0)\n\ts_barrier":::"memory")

__device__ __forceinline__ void qkt(f32x16&p0,f32x16&p1,const char*Kslot,const bf16x8*qr,bf16x8 ka0,bf16x8 ka1,bf16x8 qa,int r32,int hi){
  const char*kb=Kslot+hi*1024+r32*16;
  p0=__builtin_amdgcn_mfma_f32_32x32x16_bf16(ka0,qa,f32x16{},0,0,0);p1=__builtin_amdgcn_mfma_f32_32x32x16_bf16(ka1,qa,f32x16{},0,0,0);
  #pragma unroll
  for(int d0=0;d0<4;++d0){
    const bf16x8 b0=*reinterpret_cast<const bf16x8*>(kb+d0*2048);
    const bf16x8 b1=*reinterpret_cast<const bf16x8*>(kb+d0*2048+512);
    p0=__builtin_amdgcn_mfma_f32_32x32x16_bf16(b0,qr[d0],p0,0,0,0);p1=__builtin_amdgcn_mfma_f32_32x32x16_bf16(b1,qr[d0],p1,0,0,0);}
}
typedef __attribute__((address_space(3))) const char* lds_cptr;
typedef short v4i16_t __attribute__((ext_vector_type(4)));
__device__ __forceinline__ void kload8(bf16x8*kf,lds_cptr kp){
  kf[0]=*(const __attribute__((address_space(3))) bf16x8*)(kp);      kf[1]=*(const __attribute__((address_space(3))) bf16x8*)(kp+512);
  kf[2]=*(const __attribute__((address_space(3))) bf16x8*)(kp+2048); kf[3]=*(const __attribute__((address_space(3))) bf16x8*)(kp+2560);
  kf[4]=*(const __attribute__((address_space(3))) bf16x8*)(kp+4096); kf[5]=*(const __attribute__((address_space(3))) bf16x8*)(kp+4608);
  kf[6]=*(const __attribute__((address_space(3))) bf16x8*)(kp+6144); kf[7]=*(const __attribute__((address_space(3))) bf16x8*)(kp+6656);
}
__device__ __forceinline__ void kload2(bf16x8*kf,lds_cptr kp,int j){ kf[2*j]=*(const __attribute__((address_space(3))) bf16x8*)(kp+j*2048); kf[2*j+1]=*(const __attribute__((address_space(3))) bf16x8*)(kp+j*2048+512); }
__device__ __forceinline__ s16x4 vtr(lds_cptr p){ return __builtin_bit_cast(s16x4,__builtin_amdgcn_ds_read_tr16_b64_v4i16((__attribute__((address_space(3))) v4i16_t*)p)); }
__device__ __forceinline__ float rowmax(const f32x16&p0,const f32x16&p1){
  float a=max3f(p0[0],p0[1],p1[0]),b=max3f(p0[2],p0[3],p1[1]);a=max3f(a,p1[2],p1[3]);
  #pragma unroll
  for(int r=4;r<16;r+=4){a=max3f(a,p0[r],p0[r+1]);b=max3f(b,p0[r+2],p0[r+3]);a=max3f(a,p1[r],p1[r+1]);b=max3f(b,p1[r+2],p1[r+3]);}
  const float m=max2f(a,b);
  auto rr=__builtin_amdgcn_permlane32_swap(__float_as_uint(m),__float_as_uint(m),false,false);
  return max2f(__uint_as_float(rr[0]),__uint_as_float(rr[1]));
}
__device__ __forceinline__ void pv(f32x16*o,int vb,bf16x8 pa0,bf16x8 pa1,bf16x8 pa2,bf16x8 pa3){
  #pragma unroll
  for(int d0=0;d0<2;++d0){s16x4 lo[4],hi[4];
    #pragma unroll
    for(int ks=0;ks<4;++ks){
      asm volatile("ds_read_b64_tr_b16 %0,%1 offset:%c2":"=&v"(lo[ks]):"v"(vb),"i"(d0*4096+ks*1024):"memory");
      asm volatile("ds_read_b64_tr_b16 %0,%1 offset:%c2":"=&v"(hi[ks]):"v"(vb),"i"(d0*4096+ks*1024+512):"memory");}
    asm volatile("s_waitcnt lgkmcnt(0)":::"memory");SBAR();
    #define PK(k) (bf16x8){lo[k][0],lo[k][1],lo[k][2],lo[k][3],hi[k][0],hi[k][1],hi[k][2],hi[k][3]}
    o[d0]=__builtin_amdgcn_mfma_f32_32x32x16_bf16(pa0,PK(0),o[d0],0,0,0);
    o[d0]=__builtin_amdgcn_mfma_f32_32x32x16_bf16(pa1,PK(1),o[d0],0,0,0);
    o[d0]=__builtin_amdgcn_mfma_f32_32x32x16_bf16(pa2,PK(2),o[d0],0,0,0);
    o[d0]=__builtin_amdgcn_mfma_f32_32x32x16_bf16(pa3,PK(3),o[d0],0,0,0);
    #undef PK
  }
}

#ifndef ATTN_STORE16
#define ATTN_STORE16(p,v) (*(u32x4*)(p)=(v))
#endif
__device__ __forceinline__ void split3(float v,unsigned&p1,unsigned&p2,unsigned&p3){
  p1=cvtpk_s(v,0.f); const float r1=v-__uint_as_float(p1<<16); p2=cvtpk_s(r1,0.f); const float r2=r1-__uint_as_float(p2<<16); p3=cvtpk_s(r2,0.f); }
template<int THRL> __device__ __forceinline__ void attn_unit(int b,int h,int qb,const bf16*Q,const bf16*__restrict__ K,const bf16*__restrict__ V,bf16*O,const float*__restrict__ BIAS,const bf16*__restrict__ GATE,const int t0,char*shm,const int tid_in){
  const int tid=tid_in,lane=tid&63,r32=lane&31,hi=lane>>5; const int wid=__builtin_amdgcn_readfirstlane(tid>>6);
  const long rowbase=(long)b*SEQ; const int q0=qb*QB;
  const bf16*Qw=Q+(rowbase+q0+wid*QBLK)*DM+h*D;
  const float*Bh0=BIAS+(long)(b*NHEAD+h)*KVR;
  int lane_s=lane; asm volatile("":"+v"(lane_s));
  const long kvbase=(long)b*KVR+(long)t0*KVBLK;
  const bf16*Kh=K+kvbase*DM+h*D,*Vh=V+kvbase*DM+h*D; const float*Bh=Bh0+(long)t0*KVBLK;
  const float cq=-Bh0[128+q0+wid*QBLK+(lane_s&31)];
  const unsigned lds0=(unsigned)(uintptr_t)shm;
  float*wsf=(float*)(shm+LDS_WS)+wid*64;
  const bf16*ksrc=Kh+(long)lane*DM+wid*8;
  const bf16*vsrc=Vh+(long)(16*(wid&3)+(lane>>2))*DM+(wid>>2)*32+(lane&3)*8;
  const unsigned kdst=lds0+LDS_K+wid*1024, vdst=lds0+LDS_V+wid*1024;
  #define DMA_K(t,slot) glds16(ksrc+(long)(t)*KVBLK*DM,(unsigned)__builtin_amdgcn_readfirstlane(kdst+(slot)))
  #define DMA_V(t,slot) glds16(vsrc+(long)(t)*KVBLK*DM,(unsigned)__builtin_amdgcn_readfirstlane(vdst+(slot)))
  const int vb0=(int)(lds0+LDS_V)+((lane>>4)&1)*32+(lane&3)*8+(4*hi+((lane&15)>>2))*64;
  const char*Kbase=shm+LDS_K; bf16x8 kf[8];
  const lds_cptr shm3=(lds_cptr)shm; const lds_cptr kp0=shm3+LDS_K+hi*1024+r32*16; const lds_cptr vp0=shm3+LDS_V+((lane>>4)&1)*32+(lane&3)*8+(4*hi+((lane&15)>>2))*64;
  const int NT=4*qb+6-t0;
  DMA_K(0,0);DMA_V(0,0);DMA_K(1,SLOTB);
  bf16x8 qr[4];
  #pragma unroll
  for(int d0=0;d0<4;++d0)qr[d0]=*reinterpret_cast<const bf16x8*>(&Qw[(long)r32*DM+d0*16+hi*8]);
  float xm=cq,l_reg=0.f;f32x16 o[2];o[0]=f32x16{};o[1]=f32x16{};
  unsigned qa1,qa2;
  #define QASET() do{ unsigned p1_,p2_,p3_; split3(xm,p1_,p2_,p3_); qa1=hi?0u:(0x3F80u|(p1_<<16)); qa2=hi?0u:((p2_&0xffffu)|(p3_<<16)); }while(0)
  #define QAF(QA) do{ QA=__builtin_bit_cast(bf16x8,(u32x4){hi?0u:0x3F803F80u,qa1,qa2,0u}); }while(0)
  QASET();
  #define KAUG1(bv,KA) do{ unsigned a1_,a2_,a3_; split3((bv),a1_,a2_,a3_); \
      KA=__builtin_bit_cast(bf16x8,(u32x4){hi?0u:((a1_&0xffffu)|(a2_<<16)),hi?0u:((a3_&0xffffu)|0x3F800000u),hi?0u:0x3F803F80u,0u}); }while(0)
  float bcur=Bh[KVBLK+lane_s]; const float bt0=Bh[lane_s];
  const int qrel=wid*QBLK+r32;
  #define CMASK(P0,P1,t) do{int jb_=(t)-(NT-4); if(jb_>=0)cmask(P0,P1,jb_,qrel,hi);}while(0)
  bool resc=false;
  #define START(P0,P1) do{ const float rm=rowmax(P0,P1); resc=false; \
    { const float dl=rm; xm=fsub_s(xm,dl); QASET(); \
      _Pragma("unroll") for(int r=0;r<16;++r){P0[r]=fsub_s(P0[r],dl);P1[r]=fsub_s(P1[r],dl);} \
      } \
    _Pragma("unroll") for(int r=0;r<16;++r)P0[r]=__builtin_amdgcn_exp2f(P0[r]); }while(0)
  #define RESC() do{ if(resc){ asm volatile("s_waitcnt lgkmcnt(0)":::"memory"); \
      _Pragma("unroll") for(int d_=0;d_<2;++d_) _Pragma("unroll") for(int r=0;r<16;++r)o[d_][r]*=wsf[crow(r,hi)]; } }while(0)
  f32x16 pA0,pA1,pB0,pB1;
  int sl_prev=0,sl_cur=0,sl_next=SLOTB;
  #define ROT() do{sl_prev=sl_cur;sl_cur=sl_next;sl_next=(sl_next==(NSLOT-1)*SLOTB)?0:sl_next+SLOTB;}while(0)
  DMA_K(2,2*SLOTB);
  WAIT_BAR(3);
  { bf16x8 ka0_,ka1_,qa_; const float oth_=__shfl_xor(bt0,32); KAUG1(bt0,ka0_); KAUG1(oth_,ka1_); QAF(qa_); qkt(pA0,pA1,Kbase,qr,ka0_,ka1_,qa_,r32,hi); } asm volatile("s_nop 15\n\ts_nop 7":"+v"(pA0),"+v"(pA1));CMASK(pA0,pA1,0);
  START(pA0,pA1);
  _Pragma("unroll") for(int r=0;r<16;++r)pA1[r]=__builtin_amdgcn_exp2f(pA1[r]);
  WAIT_BAR(0);
  DMA_K(3,0);DMA_V(1,SLOTB);
  ROT();
  kload8(kf,kp0+sl_cur);
  WAIT_BAR(2);
  s16x4 vlo[8],vhi[8]; u32x4 pw0,pw1,pw2,pw3;
  #define BNEXT() do{ asm volatile("":"+v"(bcur)); }while(0)
  #define PKW(P,B) cvtpk_s(P[B],P[B+1])
  #define PAF(k) __builtin_bit_cast(bf16x8,pw##k)
  #define VFR(i) (bf16x8){vlo[i][0],vlo[i][1],vlo[i][2],vlo[i][3],vhi[i][0],vhi[i][1],vhi[i][2],vhi[i][3]}
  #define PIN(x) asm volatile("":"+v"(x))
  #define MX3(a,b,c) __builtin_fmaxf(__builtin_fmaxf((a),(b)),(c))
  #define GAPA(MF,A0,A1,A2,A3,W0,W1,PW) do{ MF; sacc+=A0; sacc+=A1; sacc+=A2; sacc+=A3; PIN(sacc); W0; W1; PIN(PW); SBAR(); }while(0)
  #define EX(v) __builtin_amdgcn_exp2f(v)
  #define GAPB(MF,X,B) do{ MF; X[B]=EX(X[B]); X[B+1]=EX(X[B+1]); X[B+2]=EX(X[B+2]); X[B+3]=EX(X[B+3]); PIN(X); SBAR(); }while(0)
  #define VRD(i) do{ vlo[i]=vtr(vp_+(((i)>>2)*4096+((i)&3)*1024)); vhi[i]=vtr(vp_+(((i)>>2)*4096+((i)&3)*1024+512)); }while(0)
  #define KRD(G,j) do{ if(G){ kload2(kf,kp0+sl_next,j); SBAR(); } }while(0)
  #define STEP(C0,C1,P0,P1,t,GK,GV,GL) do{ SBAR(); \
    const lds_cptr vp_=vp0+sl_prev; \
    { bf16x8 ka_,qa_; QAF(qa_); const float oth_=__shfl_xor(bcur,32); KAUG1(bcur,ka_); \
      if(GV){ asm volatile("global_load_dword %0, %1, off":"=v"(bcur):"v"(Bh+(long)((t)+1)*KVBLK+lane):"memory"); } \
      SBAR(); C0=__builtin_amdgcn_mfma_f32_32x32x16_bf16(ka_,qa_,f32x16{},0,0,0); SBAR(); KAUG1(oth_,ka_); C1=__builtin_amdgcn_mfma_f32_32x32x16_bf16(ka_,qa_,f32x16{},0,0,0); SBAR(); } \
    VRD(0); SBAR(); float sacc=(P0[0]+P0[1]); \
    GAPA(C0=__builtin_amdgcn_mfma_f32_32x32x16_bf16(kf[0],qr[0],C0,0,0,0), P0[2],P0[3],P0[4],P0[5],     pw0[0]=PKW(P0,0), pw0[1]=PKW(P0,2), pw0); \
    VRD(4); SBAR(); GAPA(C1=__builtin_amdgcn_mfma_f32_32x32x16_bf16(kf[1],qr[0],C1,0,0,0), P0[6],P0[7],P0[8],P0[9],     pw0[2]=PKW(P0,4), pw0[3]=PKW(P0,6), pw0); \
    VRD(1); SBAR(); GAPA(C0=__builtin_amdgcn_mfma_f32_32x32x16_bf16(kf[2],qr[1],C0,0,0,0),   P0[10],P0[11],P0[12],P0[13], pw1[0]=PKW(P0,8), pw1[1]=PKW(P0,10), pw1); \
    VRD(5); SBAR(); GAPA(C1=__builtin_amdgcn_mfma_f32_32x32x16_bf16(kf[3],qr[1],C1,0,0,0),   P0[14],P0[15],P1[0],P1[1],   pw1[2]=PKW(P0,12),pw1[3]=PKW(P0,14), pw1); \
    VRD(2); SBAR(); GAPA(C0=__builtin_amdgcn_mfma_f32_32x32x16_bf16(kf[4],qr[2],C0,0,0,0),   P1[2],P1[3],P1[4],P1[5],     pw2[0]=PKW(P1,0), pw2[1]=PKW(P1,2), pw2); \
    VRD(6); SBAR(); GAPA(C1=__builtin_amdgcn_mfma_f32_32x32x16_bf16(kf[5],qr[2],C1,0,0,0),   P1[6],P1[7],P1[8],P1[9],     pw2[2]=PKW(P1,4), pw2[3]=PKW(P1,6), pw2); \
    VRD(3); SBAR(); GAPA(C0=__builtin_amdgcn_mfma_f32_32x32x16_bf16(kf[6],qr[3],C0,0,0,0),   P1[10],P1[11],P1[12],P1[13], pw3[0]=PKW(P1,8), pw3[1]=PKW(P1,10), pw3); \
    VRD(7); SBAR(); GAPA(C1=__builtin_amdgcn_mfma_f32_32x32x16_bf16(kf[7],qr[3],C1,0,0,0),   P1[14],P1[15],0.f,0.f,       pw3[2]=PKW(P1,12),pw3[3]=PKW(P1,14), pw3); \
    l_reg+=sacc; \
    if(GK){DMA_K((t)+3,sl_cur);} if(GV){DMA_V((t)+1,sl_next);} \
    CMASK(C0,C1,t); \
    { float a=MX3(C0[0],C0[1],C1[0]),b=MX3(C0[2],C0[3],C1[1]); a=MX3(a,C1[2],C1[3]); \
      _Pragma("unroll") for(int r=4;r<16;r+=4){a=MX3(a,C0[r],C0[r+1]);b=MX3(b,C0[r+2],C0[r+3]);a=MX3(a,C1[r],C1[r+1]);b=MX3(b,C1[r+2],C1[r+3]);} \
      float rm=__builtin_fmaxf(a,b); { auto rr=__builtin_amdgcn_permlane32_swap(__float_as_uint(rm),__float_as_uint(rm),false,false); rm=__builtin_fmaxf(__uint_as_float(rr[0]),__uint_as_float(rr[1])); } \
      resc=false; \
      if(__builtin_expect(__any(rm>(float)THRL),0)){ const float dl=__builtin_fmaxf(rm,0.f); xm-=dl; QASET(); \
        _Pragma("unroll") for(int r=0;r<16;++r){C0[r]-=dl;C1[r]-=dl;} \
        const float f=__builtin_amdgcn_exp2f(-dl); l_reg*=f; if(hi==0)wsf[r32]=f; resc=true; } } \
    SBAR(); \
    GAPB(o[0]=__builtin_amdgcn_mfma_f32_32x32x16_bf16(PAF(0),VFR(0),o[0],0,0,0), C0,0); \
    GAPB(o[1]=__builtin_amdgcn_mfma_f32_32x32x16_bf16(PAF(0),VFR(4),o[1],0,0,0), C0,4); \
    KRD(GL,0); GAPB(o[0]=__builtin_amdgcn_mfma_f32_32x32x16_bf16(PAF(1),VFR(1),o[0],0,0,0), C0,8); \
    KRD(GL,1); GAPB(o[1]=__builtin_amdgcn_mfma_f32_32x32x16_bf16(PAF(1),VFR(5),o[1],0,0,0), C0,12); \
    KRD(GL,2); GAPB(o[0]=__builtin_amdgcn_mfma_f32_32x32x16_bf16(PAF(2),VFR(2),o[0],0,0,0), C1,0); \
    KRD(GL,3); GAPB(o[1]=__builtin_amdgcn_mfma_f32_32x32x16_bf16(PAF(2),VFR(6),o[1],0,0,0), C1,4); \
    GAPB(o[0]=__builtin_amdgcn_mfma_f32_32x32x16_bf16(PAF(3),VFR(3),o[0],0,0,0), C1,8); \
    GAPB(o[1]=__builtin_amdgcn_mfma_f32_32x32x16_bf16(PAF(3),VFR(7),o[1],0,0,0), C1,12); \
    }while(0)
  int t=1;
  #undef CMASK
  #define CMASK(P0,P1,t) do{}while(0)
  for(;t+5<NT;t+=2){
    STEP(pB0,pB1,pA0,pA1,t,true,true,true);     WAIT_BAR(2); BNEXT(); RESC(); ROT();
    STEP(pA0,pA1,pB0,pB1,t+1,true,true,true);   WAIT_BAR(2); BNEXT(); RESC(); ROT();
  }
  #undef CMASK
  #define CMASK(P0,P1,t) do{int jb_=(t)-(NT-4); if(jb_>=0)cmask(P0,P1,jb_,qrel,hi);}while(0)
  #define ENDW(tt) do{ if((tt)+3<NT){WAIT_BAR(2);} else if((tt)+2<NT){WAIT_BAR(1);} else {WAIT_BAR(0);} }while(0)
  for(;t+1<NT;t+=2){
    STEP(pB0,pB1,pA0,pA1,t,(t+3<NT),(t+1<NT),(t+1<NT));       ENDW(t);   BNEXT(); RESC(); ROT();
    STEP(pA0,pA1,pB0,pB1,t+1,(t+4<NT),(t+2<NT),(t+2<NT));     ENDW(t+1); BNEXT(); RESC(); ROT();
  }
  STEP(pB0,pB1,pA0,pA1,NT-1,false,false,false); RESC();
  { float sacc=pB0[0]+pB0[1]; _Pragma("unroll") for(int r=2;r<16;++r)sacc+=pB0[r]; _Pragma("unroll") for(int r=0;r<16;++r)sacc+=pB1[r]; l_reg+=sacc;
    pw0=(u32x4){PKW(pB0,0),PKW(pB0,2),PKW(pB0,4),PKW(pB0,6)};pw1=(u32x4){PKW(pB0,8),PKW(pB0,10),PKW(pB0,12),PKW(pB0,14)};pw2=(u32x4){PKW(pB1,0),PKW(pB1,2),PKW(pB1,4),PKW(pB1,6)};pw3=(u32x4){PKW(pB1,8),PKW(pB1,10),PKW(pB1,12),PKW(pB1,14)};
    SBAR(); pv(o,vb0+sl_cur,PAF(0),PAF(1),PAF(2),PAF(3)); }
  #undef PKW
  #undef PAF
  #undef VFR
  #undef PIN
  #undef MX3
  #undef GAPA
  #undef GAPB
  #undef EX
  #undef VRD
  #undef KRD
  #undef STEP
  #undef ENDW
  {auto rr=__builtin_amdgcn_permlane32_swap(__float_as_uint(l_reg),__float_as_uint(l_reg),false,false);l_reg=__uint_as_float(rr[0])+__uint_as_float(rr[1]);}
  if(hi==0)wsf[32+r32]=l_reg;asm volatile("s_waitcnt lgkmcnt(0)":::"memory");
  float rli[16];
  #pragma unroll
  for(int r=0;r<16;++r)rli[r]=__builtin_amdgcn_rcpf(wsf[32+crow(r,hi)]);
  bf16*Ow=O+(rowbase+q0+wid*QBLK)*DM+h*D;
  { bf16*stg=(bf16*)(shm+LDS_OST)+wid*2048;
    #pragma unroll
    for(int r=0;r<16;++r){const int orow=crow(r,hi);
      #pragma unroll
      for(int d0=0;d0<2;++d0)stg[orow*64+d0*32+r32]=__float2bfloat16(o[d0][r]*rli[r]);}
    asm volatile("s_waitcnt lgkmcnt(0)":::"memory");
    const bf16*Gw=GATE+(rowbase+q0+wid*QBLK)*DM+h*D;
    #pragma unroll
    for(int i=0;i<4;++i){const int row=i*8+(lane>>3),ch=lane&7; const u32x4 v=*(const u32x4*)(stg+row*64+ch*8); const u32x4 g=*(const u32x4*)(Gw+(long)row*DM+ch*8); u32x4 w;
      #pragma unroll
      for(int e=0;e<4;++e){ const float lo=__uint_as_float(v[e]<<16)*__uint_as_float(g[e]<<16), hh=__uint_as_float(v[e]&0xffff0000u)*__uint_as_float(g[e]&0xffff0000u); w[e]=cvtpk_s(lo,hh); }
      ATTN_STORE16(Ow+(long)row*DM+ch*8,w);} }
  asm volatile("s_waitcnt lgkmcnt(0)\n\ts_barrier":::"memory");
  #undef DMA_K
  #undef DMA_V
  #undef CMASK
  #undef START
  #undef RESC
  #undef ROT
}
constexpr int ATTN_LDS_BYTES=LDS_BYTES;
struct AttnTensors { const bf16* Q; const bf16* K; const bf16* V; bf16* O; const float* BIAS; const bf16* GATE; float skipc; const int* T0; };
struct AttnUnit { int bh; int qb; };
struct StaticOrder {
  int vcu;
  __device__ __forceinline__ explicit StaticOrder(int grid,int block):vcu((block%8)*(grid/8)+block/8){}
  __device__ __forceinline__ bool next(int i,AttnUnit&u)const{ if(i>=4)return false; const int s=vcu&7; u.bh=vcu>>3; u.qb=(i==0)?s:(i==1)?15-s:(i==2)?16+s:31-s; return true; }
  __device__ __forceinline__ void a_ready(const AttnUnit&)const{}
  __device__ __forceinline__ void done(const AttnUnit&)const{}
};
template<class Sched,int THRL=8> __device__ __forceinline__ void attn_phase(char*lds,const AttnTensors&T,const Sched&S,const int tid_in){
  AttnUnit u,un;
  if(!S.next(0,u))return;
  int t0n=T.T0[u.bh*32+u.qb];
  for(int i=0;;++i){ const int t0=t0n; const bool more=S.next(i+1,un); if(more)t0n=T.T0[un.bh*32+un.qb];
    S.a_ready(u); attn_unit<THRL>(u.bh/NHEAD,u.bh%NHEAD,u.qb,T.Q,T.K,T.V,T.O,T.BIAS,T.GATE,t0,lds,tid_in); S.done(u); if(!more)break; u=un; }
}
#undef SBAR
#undef WAIT_BAR
}

namespace hg {
#define LDS_BAR() asm volatile("s_waitcnt lgkmcnt(0)\n\ts_barrier" ::: "memory")
typedef short v4i16_t __attribute__((ext_vector_type(4)));
constexpr int PT = 72, PV = 136;
constexpr int O_QH = 0, O_QT = 18432, O_KT = 36864, O_KP = 55296, O_VT = 73728, O_SC = 91136, O_SEG = 100352  , O_DEC = 104448, O_PART = 104960, O_END = 107008;
constexpr int O_OT = O_QT;
constexpr int NSC = 32;

__device__ __forceinline__ bf16x8 tr_frag(const LAS unsigned char* img, int pitchB, int ka, int kb, int col0, int fr) {
    const LAS unsigned char* p = img + (fr >> 2) * pitchB + (col0 + 4 * (fr & 3)) * 2;
    const v4i16_t a = __builtin_amdgcn_ds_read_tr16_b64_v4i16((LAS v4i16_t*)(p + ka * pitchB));
    const v4i16_t b = __builtin_amdgcn_ds_read_tr16_b64_v4i16((LAS v4i16_t*)(p + kb * pitchB));
    return (bf16x8){a[0], a[1], a[2], a[3], b[0], b[1], b[2], b[3]};
}

struct UnitCtx { const bf16_t* QH; const _Float16* LF; const bf16_t* VH; const bf16_t* G; bf16_t* OH; const float* MW; const float* MSSQ; const float* lbt; const float* og; bf16_t* MA; };
struct ChunkRegs { unsigned lf2[8]; unsigned qs2[8]; v4u v[2]; };
__device__ __forceinline__ float h2f_lo(unsigned u) { return (float)__builtin_bit_cast(_Float16, (unsigned short)(u & 0xffffu)); }
__device__ __forceinline__ float h2f_hi(unsigned u) { return (float)__builtin_bit_cast(_Float16, (unsigned short)(u >> 16)); }
__device__ __forceinline__ unsigned f2h2(float a, float b) { return (unsigned)__builtin_bit_cast(unsigned short, (_Float16)a) | ((unsigned)__builtin_bit_cast(unsigned short, (_Float16)b) << 16); }

template <bool OUT> __device__ __forceinline__ void load_main(ChunkRegs& R, const UnitCtx& C, int row0, int cb, int tid) {
    const int kp = tid & 63, te = tid >> 6;
    const unsigned* lf = (const unsigned*)(C.LF + (size_t)(row0 + 8 * te) * D + cb) + kp; const unsigned* qh = (const unsigned*)(C.QH + (size_t)(row0 + 8 * te) * D + cb) + kp;
#pragma unroll
    for (int j = 0; j < 8; ++j) { R.lf2[j] = lf[(size_t)j * (D / 2)]; R.qs2[j] = OUT ? qh[(size_t)j * (D / 2)] : 0u; }
#pragma unroll
    for (int i = 0; i < 2; ++i) { const int p = tid + NTHREADS * i, row = p >> 4, ch = p & 15; R.v[i] = *(const v4u*)(C.VH + (size_t)(row0 + row) * D + cb + 8 * ch); }
}
__device__ __forceinline__ void load_meta(ChunkRegs& R, v4u (&g)[2], const UnitCtx& C, int cb, int tid) {
    const int kp = tid & 63, te = tid >> 6, k0 = cb + 2 * kp;
    const float lba = C.lbt[k0], lbb = C.lbt[k0 + 1];
#pragma unroll
    for (int j = 0; j < 8; ++j) {
        const int t = 8 * te + j;
        if (te < 2) { const float rs = rsqrtf(C.MSSQ[t] * (1.f / D) + EPS); const float* mr = C.MW + (size_t)t * 4 * D + k0;
            const float qa = rs * mr[0], qb = rs * mr[1];
            R.lf2[j] = f2h2(__logf(lba + (1.f - lba) * sigm(rs * mr[D])), __logf(lbb + (1.f - lbb) * sigm(rs * mr[D + 1]))); R.qs2[j] = pk2(qa * sigm(qa), qb * sigm(qb)); }
        else { R.lf2[j] = 0u; R.qs2[j] = 0u; }
    }
#pragma unroll
    for (int i = 0; i < 2; ++i) {
        const int p = tid + NTHREADS * i, row = p >> 4, ch = p & 15; R.v[i] = (v4u){0u, 0u, 0u, 0u}; g[i] = (v4u){0u, 0u, 0u, 0u};
        if (row < NMETA) { const float rs = rsqrtf(C.MSSQ[row] * (1.f / D) + EPS); const float* mr = C.MW + (size_t)row * 4 * D + 2 * D + cb + 8 * ch; float x[8], y[8];
#pragma unroll
            for (int e = 0; e < 8; ++e) { x[e] = rs * mr[e]; y[e] = sigm(rs * mr[D + e]); }
            R.v[i] = pack8(x); g[i] = pack8(y); }
    }
}

template <bool OUT, bool META> __device__ __forceinline__ void chunk(Frame& F, const UnitCtx& C, f32x4 (&S)[8], float (&logdec)[2], ChunkRegs& R, v4u (&gm)[2], int row0, int next_row0, int cb, bool write_meta) {
    LAS unsigned char* lds = F.lds;
    LAS bf16_t* QHs = (LAS bf16_t*)(lds + O_QH); LAS bf16_t* QTs = (LAS bf16_t*)(lds + O_QT); LAS bf16_t* KTs = (LAS bf16_t*)(lds + O_KT);
    LAS bf16_t* VTs = (LAS bf16_t*)(lds + O_VT); LAS bf16_t* KPs = (LAS bf16_t*)(lds + O_KP); LAS bf16_t* SCs = (LAS bf16_t*)(lds + O_SC); LAS bf16_t* OTs = (LAS bf16_t*)(lds + O_OT);
    LAS float* SEG = (LAS float*)(lds + O_SEG); LAS float* DEC = (LAS float*)(lds + O_DEC); LAS float* PART = (LAS float*)(lds + O_PART);
    int lane_l = F.lane; asm volatile("" : "+v"(lane_l));
    const int lane = lane_l, w = F.wave, tid = w * 64 + lane, fr = lane & 15, fq = lane >> 4;
    const int kp = lane, te = w;

    v4u g[2];
    if (OUT) {
#pragma unroll
        for (int i = 0; i < 2; ++i) { const int p = tid + NTHREADS * i, row = p >> 4, ch = p & 15; g[i] = META ? gm[i] : *(const v4u*)(C.G + (size_t)(row0 + row) * D + cb + 8 * ch); }
    }
    float lfa[8], lfb[8], pa[8], pb[8]; float runa = 0.f, runb = 0.f;
#pragma unroll
    for (int j = 0; j < 8; ++j) { lfa[j] = h2f_lo(R.lf2[j]); lfb[j] = h2f_hi(R.lf2[j]); runa += lfa[j]; runb += lfb[j]; pa[j] = runa; pb[j] = runb; }
    typedef float f32x2l __attribute__((ext_vector_type(2)));
    *(LAS f32x2l*)(SEG + te * 128 + 2 * kp) = (f32x2l){runa, runb};
    LDS_BAR();
    {
        float offa = 0.f, offb = 0.f, bma = 0.f, bmb = 0.f, benda = 0.f, bendb = 0.f;
#pragma unroll
        for (int q = 0; q < 8; ++q) { const f32x2l s = *(const LAS f32x2l*)(SEG + q * 128 + 2 * kp); if (q < te) { offa += s.x; offb += s.y; } if (q < 4) { bma += s.x; bmb += s.y; } benda += s.x; bendb += s.y; }
        if (te == 0) { *(LAS f32x2l*)(DEC + 2 * kp) = (f32x2l){__expf(benda), __expf(bendb)}; logdec[0] += benda; logdec[1] += bendb; }
        const float c1a = __expf(bma), c1b = __expf(bmb), c2a = __expf(benda - bma), c2b = __expf(bendb - bmb);
        float qta[8], kta[8], qtb[8], ktb[8];
#pragma unroll
        for (int j = 0; j < 8; ++j) {
            const float Ea = __expf(offa + pa[j] - bma), Eb = __expf(offb + pb[j] - bmb);
            qta[j] = __uint_as_float(R.qs2[j] << 16) * Ea; qtb[j] = __uint_as_float(R.qs2[j] & 0xffff0000u) * Eb;
            kta[j] = (1.f - __expf(lfa[j])) * __builtin_amdgcn_rcpf(Ea); ktb[j] = (1.f - __expf(lfb[j])) * __builtin_amdgcn_rcpf(Eb);
        }
        const int oa = (2 * kp) * PT + 8 * te, ob = oa + PT;
        float t8[8];
        if (OUT) {
            *(LAS v4u*)(QTs + oa) = pack8(qta); *(LAS v4u*)(QTs + ob) = pack8(qtb);
            *(LAS v4u*)(KTs + oa) = pack8(kta); *(LAS v4u*)(KTs + ob) = pack8(ktb);
#pragma unroll
            for (int e = 0; e < 8; ++e) t8[e] = qta[e] * c1a;
            *(LAS v4u*)(QHs + oa) = pack8(t8);
#pragma unroll
            for (int e = 0; e < 8; ++e) t8[e] = qtb[e] * c1b;
            *(LAS v4u*)(QHs + ob) = pack8(t8);
        }
#pragma unroll
        for (int e = 0; e < 8; ++e) t8[e] = kta[e] * c2a;
        *(LAS v4u*)(KPs + oa) = pack8(t8);
#pragma unroll
        for (int e = 0; e < 8; ++e) t8[e] = ktb[e] * c2b;
        *(LAS v4u*)(KPs + ob) = pack8(t8);
    }
#pragma unroll
    for (int i = 0; i < 2; ++i) { const int p = tid + NTHREADS * i, row = p >> 4, ch = p & 15; *(LAS v4u*)(VTs + row * PV + 8 * ch) = R.v[i]; }
    LDS_BAR();

    if (!META && next_row0 >= 0) load_main<OUT>(R, C, next_row0, cb, tid);

    bf16x8 vf[2];
    vf[0] = tr_frag((const LAS unsigned char*)VTs, PV * 2, 8 * fq, 8 * fq + 4, 16 * w, fr); vf[1] = tr_frag((const LAS unsigned char*)VTs, PV * 2, 32 + 8 * fq, 32 + 8 * fq + 4, 16 * w, fr);
    if (OUT) {
#pragma unroll
        for (int bb = 0; bb < 2; ++bb) {
            const int bi = 2 * w + bb, tb = bi >> 2, sb = bi & 3;
            f32x4 c = (f32x4){0.f, 0.f, 0.f, 0.f};
            if (sb <= tb) {
#pragma unroll
                for (int ks = 0; ks < 4; ++ks) { const bf16x8 a = tr_frag((const LAS unsigned char*)QTs, PT * 2, 32 * ks + 8 * fq, 32 * ks + 8 * fq + 4, 16 * tb, fr), b = tr_frag((const LAS unsigned char*)KTs, PT * 2, 32 * ks + 8 * fq, 32 * ks + 8 * fq + 4, 16 * sb, fr);
                    c = __builtin_amdgcn_mfma_f32_16x16x32_bf16(a, b, c, 0, 0, 0); }
            }
#pragma unroll
            for (int e = 0; e < 4; ++e) { const int t = 16 * tb + 4 * fq + e, s = 16 * sb + fr; SCs[t * PT + s] = (bf16_t)f2bf(s <= t ? c[e] : 0.f); }
        }
        LDS_BAR();

        bf16x8 sfr[4];
#pragma unroll
        for (int ks = 0; ks < 4; ++ks) { const f32x4 x0 = S[2 * ks], x1 = S[2 * ks + 1]; const v4u wv = (v4u){pk2(x0[0], x0[1]), pk2(x0[2], x0[3]), pk2(x1[0], x1[1]), pk2(x1[2], x1[3])}; sfr[ks] = __builtin_bit_cast(bf16x8, wv); }
        f32x4 o[4];
#pragma unroll
        for (int tb = 0; tb < 4; ++tb) {
            o[tb] = (f32x4){0.f, 0.f, 0.f, 0.f};
#pragma unroll
            for (int ks = 0; ks < 2; ++ks) { const bf16x8 a = *(const LAS bf16x8*)(SCs + (16 * tb + fr) * PT + 32 * ks + 8 * fq); o[tb] = __builtin_amdgcn_mfma_f32_16x16x32_bf16(a, vf[ks], o[tb], 0, 0, 0); }
#pragma unroll
            for (int ks = 0; ks < 4; ++ks) { const bf16x8 a = tr_frag((const LAS unsigned char*)QHs, PT * 2, 32 * ks + 4 * fq, 32 * ks + 16 + 4 * fq, 16 * tb, fr); o[tb] = __builtin_amdgcn_mfma_f32_16x16x32_bf16(a, sfr[ks], o[tb], 0, 0, 0); }
        }
#pragma unroll
        for (int tb = 0; tb < 4; ++tb)
#pragma unroll
            for (int e = 0; e < 4; ++e) OTs[(16 * tb + 4 * fq + e) * PV + 16 * w + fr] = (bf16_t)f2bf(o[tb][e]);
        LDS_BAR();

#pragma unroll
        for (int i = 0; i < 2; ++i) {
            const int p = tid + NTHREADS * i, row = p >> 4, ch = p & 15;
            float ov[8], gv[8]; unpack8(*(const LAS v4u*)(OTs + row * PV + 8 * ch), ov); unpack8(g[i], gv);
            float q = 0.f;
#pragma unroll
            for (int e = 0; e < 8; ++e) q += ov[e] * ov[e];
            q = row16_sum(q);
            const float rsn = rsqrtf(q * (1.f / DK) + EPS);
            const f32x4 g0 = *(const f32x4*)(C.og + 8 * ch), g1 = *(const f32x4*)(C.og + 8 * ch + 4);
#pragma unroll
            for (int e = 0; e < 8; ++e) ov[e] = ov[e] * rsn * (e < 4 ? g0[e & 3] : g1[e & 3]) * gv[e];
            if (!META) *(v4u*)(C.OH + (size_t)(row0 + row) * D + cb + 8 * ch) = pack8(ov);
            else if (write_meta && row < NMETA) *(v4u*)(C.MA + (size_t)row * D + cb + 8 * ch) = pack8(ov);
        }
    }

#pragma unroll
    for (int mb = 0; mb < 8; ++mb) {
        const f32x4 dv4 = *(const LAS f32x4*)(DEC + 16 * mb + 4 * fq);
        S[mb] = S[mb] * dv4;
#pragma unroll
        for (int ks = 0; ks < 2; ++ks) { const bf16x8 a = *(const LAS bf16x8*)(KPs + (16 * mb + fr) * PT + 32 * ks + 8 * fq); S[mb] = __builtin_amdgcn_mfma_f32_16x16x32_bf16(a, vf[ks], S[mb], 0, 0, 0); }
    }

}

constexpr int P1K = 264, O1_KP = 0, O1_VT = 128 * P1K * 2, O1_DEC = O1_VT + 256 * PV * 2, O1_BS = O1_DEC + 2048, O1_END = O1_BS + 4096;
static_assert(O1_END <= 147456 - 256, "pass-1 LDS map");
__device__ __forceinline__ void superchunk_state(Frame& F, const UnitCtx& C, f32x4 (&S)[8], float (&logdec)[2], int row0, int cb) {
    LAS unsigned char* lds = F.lds;
    LAS bf16_t* KPs = (LAS bf16_t*)(lds + O1_KP); LAS bf16_t* VTs = (LAS bf16_t*)(lds + O1_VT); LAS float* DEC = (LAS float*)(lds + O1_DEC); LAS float* BS = (LAS float*)(lds + O1_BS);
    int lane_l = F.lane; asm volatile("" : "+v"(lane_l));
    const int lane = lane_l, w = F.wave, tid = w * 64 + lane, fr = lane & 15, fq = lane >> 4;
    const int kp = lane, c = w >> 1, hf = w & 1;
    typedef float f32x2l __attribute__((ext_vector_type(2)));
    v4u vv[8];
#pragma unroll
    for (int i = 0; i < 8; ++i) { const int p = tid + NTHREADS * i, row = p >> 4, ch = p & 15; vv[i] = *(const v4u*)(C.VH + (size_t)(row0 + row) * D + cb + 8 * ch); }
    const unsigned* lf = (const unsigned*)(C.LF + (size_t)(row0 + 32 * w) * D + cb) + kp;
    unsigned lf2[32];
#pragma unroll
    for (int j = 0; j < 32; ++j) lf2[j] = lf[(size_t)j * (D / 2)];
    float ha = 0.f, hb = 0.f;
#pragma unroll
    for (int j = 0; j < 32; ++j) { ha += h2f_lo(lf2[j]); hb += h2f_hi(lf2[j]); }
    *(LAS f32x2l*)(BS + w * 128 + 2 * kp) = (f32x2l){ha, hb};
#pragma unroll
    for (int i = 0; i < 8; ++i) { const int p = tid + NTHREADS * i, row = p >> 4, ch = p & 15; *(LAS v4u*)(VTs + row * PV + 8 * ch) = vv[i]; }
    LDS_BAR();
    {
        const f32x2l s0 = *(const LAS f32x2l*)(BS + (2 * c) * 128 + 2 * kp), s1 = *(const LAS f32x2l*)(BS + (2 * c + 1) * 128 + 2 * kp);
        const float benda = s0.x + s1.x, bendb = s0.y + s1.y;
        if (hf == 0) *(LAS f32x2l*)(DEC + c * 128 + 2 * kp) = (f32x2l){__expf(benda), __expf(bendb)};
        float ra = hf ? s0.x : 0.f, rb = hf ? s0.y : 0.f;
#pragma unroll
        for (int g8 = 0; g8 < 4; ++g8) {
            float ta[8], tb[8];
#pragma unroll
            for (int j = 0; j < 8; ++j) { const float la = h2f_lo(lf2[8 * g8 + j]), lb = h2f_hi(lf2[8 * g8 + j]); ra += la; rb += lb;
                ta[j] = (1.f - __expf(la)) * __expf(benda - ra); tb[j] = (1.f - __expf(lb)) * __expf(bendb - rb); }
            *(LAS v4u*)(KPs + (2 * kp) * P1K + 32 * w + 8 * g8) = pack8(ta);
            *(LAS v4u*)(KPs + (2 * kp + 1) * P1K + 32 * w + 8 * g8) = pack8(tb);
        }
    }
    LDS_BAR();
    if (w == 0) {
#pragma unroll
        for (int q = 0; q < 8; ++q) { const f32x2l s = *(const LAS f32x2l*)(BS + q * 128 + 2 * lane); logdec[0] += s.x; logdec[1] += s.y; }
    }
#pragma unroll
    for (int cc = 0; cc < 4; ++cc) {
#pragma unroll
        for (int mb = 0; mb < 8; ++mb) { const f32x4 dv4 = *(const LAS f32x4*)(DEC + cc * 128 + 16 * mb + 4 * fq); S[mb] = S[mb] * dv4; }
#pragma unroll
        for (int ks = 0; ks < 2; ++ks) {
            const int t0 = 64 * cc + 32 * ks;
            const bf16x8 vf = tr_frag((const LAS unsigned char*)VTs, PV * 2, t0 + 8 * fq, t0 + 8 * fq + 4, 16 * w, fr);
#pragma unroll
            for (int mb = 0; mb < 8; ++mb) { const bf16x8 a = *(const LAS bf16x8*)(KPs + (16 * mb + fr) * P1K + t0 + 8 * fq); S[mb] = __builtin_amdgcn_mfma_f32_16x16x32_bf16(a, vf, S[mb], 0, 0, 0); }
        }
    }
    LDS_BAR();
}

template <bool OUT> __device__ __forceinline__ void unit(Frame& F, const UnitCtx& C, int u, float* ST, float* DECG) {
    const int bh = u >> 5, sc = u & 31, b = bh >> 3, h = bh & 7, cb = h * DK, row_sc = b * SEQ + 256 * sc;
    int lane_l = F.lane; asm volatile("" : "+v"(lane_l));
    const int lane = lane_l, w = F.wave, tid = w * 64 + lane, fr = lane & 15, fq = lane >> 4;
    bf16_t* st = (bf16_t*)ST + (size_t)u * DK * DK + (size_t)(16 * w + fr) * DK + 32 * fq;
    f32x4 S[8]; float logdec[2] = {0.f, 0.f};
    if (OUT) {
        v4u sw[4];
#pragma unroll
        for (int q = 0; q < 4; ++q) sw[q] = *(const v4u*)(st + 8 * q);
#pragma unroll
        for (int q = 0; q < 4; ++q) {
            S[2 * q] = (f32x4){__uint_as_float(sw[q].x << 16), __uint_as_float(sw[q].x & 0xffff0000u), __uint_as_float(sw[q].y << 16), __uint_as_float(sw[q].y & 0xffff0000u)};
            S[2 * q + 1] = (f32x4){__uint_as_float(sw[q].z << 16), __uint_as_float(sw[q].z & 0xffff0000u), __uint_as_float(sw[q].w << 16), __uint_as_float(sw[q].w & 0xffff0000u)}; }
    } else {
#pragma unroll
        for (int mb = 0; mb < 8; ++mb) S[mb] = (f32x4){0.f, 0.f, 0.f, 0.f};
    }
    ChunkRegs R; v4u gm[2] = {(v4u){0u, 0u, 0u, 0u}, (v4u){0u, 0u, 0u, 0u}};
    if (sc == 0) { load_meta(R, gm, C, cb, tid); chunk<OUT, true>(F, C, S, logdec, R, gm, 0, -1, cb, b == 0); }
    if (!OUT) superchunk_state(F, C, S, logdec, row_sc, cb);
    else {
        load_main<OUT>(R, C, row_sc, cb, tid);
        for (int c = 0; c < 4; ++c) chunk<OUT, false>(F, C, S, logdec, R, gm, row_sc + 64 * c, c < 3 ? row_sc + 64 * (c + 1) : -1, cb, false);
    }
    if (!OUT) {
#pragma unroll
        for (int q = 0; q < 4; ++q) *(v4u*)(st + 8 * q) = (v4u){pk2(S[2 * q][0], S[2 * q][1]), pk2(S[2 * q][2], S[2 * q][3]), pk2(S[2 * q + 1][0], S[2 * q + 1][1]), pk2(S[2 * q + 1][2], S[2 * q + 1][3])};
        if (w == 0) { DECG[(size_t)u * DK + 2 * lane] = __expf(logdec[0]); DECG[(size_t)u * DK + 2 * lane + 1] = __expf(logdec[1]); }
    }
    __syncthreads();
}
__device__ __forceinline__ void scan(Frame& F, float* ST, const float* __restrict__ DECG) {
    typedef float f32x2s __attribute__((ext_vector_type(2)));
    const int gid = F.bid * NTHREADS + F.tid, nthr = F.G * NTHREADS;
    for (int e = gid; e < NB * HH * DK * DK / 2; e += nthr) {
        const int bh = e >> 13, idx2 = e & 8191, pos = (2 * idx2) & 127, dk = 16 * ((pos >> 2) & 7) + 4 * (pos >> 5) + (pos & 3);
        unsigned* p = (unsigned*)ST + (size_t)bh * NSC * (DK * DK / 2) + idx2; const float* dp = DECG + (size_t)bh * NSC * DK + dk;
        unsigned uu[NSC]; f32x2s dd[NSC];
#pragma unroll
        for (int sc = 0; sc < NSC; ++sc) { uu[sc] = p[(size_t)sc * (DK * DK / 2)]; dd[sc] = *(const f32x2s*)(dp + sc * DK); }
        float s0 = 0.f, s1 = 0.f;
#pragma unroll
        for (int sc = 0; sc < NSC; ++sc) { p[(size_t)sc * (DK * DK / 2)] = pk2(s0, s1); s0 = dd[sc].x * s0 + __uint_as_float(uu[sc] << 16); s1 = dd[sc].y * s1 + __uint_as_float(uu[sc] & 0xffff0000u); }
    }
}
}

enum { PH_PRO = 0, PH_FOXIN, PH_SCAN, PH_ATTN, PH_FOXOUT, PH_GATE0, PH_UP0, PH_DOWN0, PH_HGIN, PH_HG1, PH_HG2, PH_HG3, PH_HGOUT, PH_GATE1, PH_UP1, PH_DOWN1, NPH,
       PH_T_FFNPREP0 = 32, PH_T_FFNPREP1 = 33, PH_T_FFNPOST = 34, PH_T_FOXPOST = 35, PH_T_HGPREP = 36, PH_T_HGPOST = 37 };
struct Args { const float* in[19]; float* out; unsigned char* ws; int ph_lo, ph_hi, pad0, pad1; };
enum { I_X = 0, I_META, I_FOXNORM, I_FOXWIN, I_FOXBF, I_FOXQG, I_FOXKG, I_FOXWOUT, I_HGNORM, I_HGWIN, I_HGLB, I_HGOG, I_HGWOUT, I_FFNNORM, I_FFNWG, I_FFNWU, I_FFNCW, I_FFNCB, I_FFNWD };

template <bool ABF16> __device__ __forceinline__ void side_gemm_wg(Frame& F, const void* A1, const float* A2, const bf16_t* Wt, int N, int K, float* out, int hidx, int nh) {
    const int lane = F.lane, fr = lane & 15, fq = lane >> 4, steps = K / 32 / NWAVES;
    LAS f32x4* red = (LAS f32x4*)(F.lds + MISC_OFF + 1024);
    for (int tile = hidx; tile < N / 16; tile += nh) {
        f32x4 acc = (f32x4){0.f, 0.f, 0.f, 0.f};
        const bf16_t* wrow = Wt + (size_t)(tile * 16 + fr) * K + 8 * fq;
        const int kbeg = F.wave * steps * 32;
#pragma unroll 2
        for (int s = 0; s < steps; ++s) {
            const int k0 = kbeg + s * 32;
            const bf16x8 b = *(const bf16x8*)(wrow + k0);
            bf16x8 a;
            if (ABF16) a = *(const bf16x8*)((const bf16_t*)A1 + (size_t)fr * K + k0 + 8 * fq);
            else {
                const float* p = (const float*)A1 + (size_t)fr * K + k0 + 8 * fq;
                f32x4 x0 = *(const f32x4*)p, x1 = *(const f32x4*)(p + 4);
                if (A2) { const float* q = A2 + (size_t)fr * K + k0 + 8 * fq; x0 += *(const f32x4*)q; x1 += *(const f32x4*)(q + 4); }
                const v4u w = (v4u){pk2(x0.x, x0.y), pk2(x0.z, x0.w), pk2(x1.x, x1.y), pk2(x1.z, x1.w)};
                a = __builtin_bit_cast(bf16x8, w);
            }
            acc = __builtin_amdgcn_mfma_f32_16x16x32_bf16(a, b, acc, 0, 0, 0);
        }
        red[F.wave * 64 + lane] = acc;
        __syncthreads();
        if (F.tid < 64) {
            f32x4 s = red[lane];
#pragma unroll
            for (int w = 1; w < NWAVES; ++w) s += red[w * 64 + lane];
#pragma unroll
            for (int e = 0; e < 4; ++e) out[(size_t)(4 * fq + e) * N + tile * 16 + fr] = s[e];
        }
        __syncthreads();
    }
}

__device__ __forceinline__ void ffn_convert(Frame& F, const Args& a, int layer, int gw, int ngw) {
    F.refresh(); unsigned char* ws = F.ws;
    const float* g = a.in[I_FFNNORM] + (size_t)layer * D;
    conv_matrix<0>(F, a.in[I_FFNWG] + (size_t)layer * D * FF, FF, D, FF, (bf16_t*)(ws + WS_WG), g, gw, ngw);
    conv_matrix<0>(F, a.in[I_FFNWU] + (size_t)layer * D * FF, FF, D, FF, (bf16_t*)(ws + WS_WU), g, gw, ngw);
    conv_matrix<0>(F, a.in[I_FFNWD] + (size_t)layer * FF * D, D, FF, D, (bf16_t*)(ws + WS_WD), nullptr, gw, ngw);
}


__device__ __forceinline__ void hg_convert(Frame& F, const Args& args, int gw, int NGW);
#ifndef ALIGN_UP
#define ALIGN_UP true
#endif
#ifndef ALIGN_IN
#define ALIGN_IN true
#endif
#ifndef ALIGN_GATE
#define ALIGN_GATE true
#endif
#ifndef UP_ORDER
#define UP_ORDER pg8::StaticOrder
#endif
#ifndef SKIP_LOG2
#define SKIP_LOG2 48.f
#endif
#ifndef ATTN_THRL
#define ATTN_THRL 32
#endif
#ifndef FOXOUT_BASE
#define FOXOUT_BASE nullptr
#endif
struct Ptrs { float* SSQ; bf16_t* HB; float *HMA, *HMB, *MW, *MW2, *MW3, *MWG, *MWU, *MSSQ; bf16_t *MY, *MA; };

template <int LAYER> __device__ __forceinline__ void phase_gate(Frame& F, const Args& args, const Ptrs& P) {
    F.refresh(); unsigned char* ws = F.ws;
    auto pre = [&]() {
    if (F.G == 256) {
        side_gemm_wg<false>(F, P.HMA, P.MW2, (const bf16_t*)(ws + WS_WG), FF, D, P.MWG, F.bid, F.G);
        if (LAYER == 0) side_gemm_wg<false>(F, P.HMA, P.MW2, (const bf16_t*)(ws + WS_WU), FF, D, P.MWU, F.bid >= FF / 16 ? F.bid - FF / 16 : F.bid + (256 - FF / 16), F.G);
    } else {
        const int hfirst = (F.G * 3) / 4;
        if (F.bid >= hfirst) {
            const int nh = F.G - hfirst, hidx = F.bid - hfirst;
            side_gemm_wg<false>(F, P.HMA, P.MW2, (const bf16_t*)(ws + WS_WG), FF, D, P.MWG, hidx, nh);
            side_gemm_wg<false>(F, P.HMA, P.MW2, (const bf16_t*)(ws + WS_WU), FF, D, P.MWU, hidx, nh);
        }
    } };
    if (F.bid == F.G - 1) meta_consolidate(P.HMA, P.MW2, P.HMB, P.MSSQ, F.wave, F.lane);
    pg8::Gemm g{P.HB, (const bf16_t*)(ws + WS_WG), M, FF, D}; pg8::PartOrder S; S.init(M, FF, F.G, F.bid);
    EpiGate E{(bf16_t*)(ws + WS_A), P.SSQ};
    pre(); __syncthreads();
    pg8::gemm_phase<EpiGate, pg8::PartOrder, ALIGN_GATE, true, true>(F.lds, g, S, E, F.tid);
}
template <int LAYER> __device__ __forceinline__ void phase_up(Frame& F, const Args& args, const Ptrs& P) {
    F.refresh(); unsigned char* ws = F.ws;
    const float* cw = args.in[I_FFNCW] + (size_t)LAYER * 3 * FF; const float* cb = args.in[I_FFNCB] + (size_t)LAYER * FF;
#ifndef TEST_BUILD
    { const int hfirst = (F.G * 3) / 4;
      if (LAYER == 0 && F.bid >= hfirst) { hg_convert(F, args, (F.bid - hfirst) * NWAVES + F.wave, (F.G - hfirst) * NWAVES); __syncthreads(); } }
#endif
    { const int hfirst = (F.G * 3) / 4;
      if (LAYER == 0 && F.bid >= hfirst) {
        for (int idx = (F.bid - hfirst) * NTHREADS + F.tid; idx < NMETA * FF; idx += (F.G - hfirst) * NTHREADS) {
            const int m = idx / FF, f = idx - m * FF;
            const float r0 = rsqrtf(P.MSSQ[m] * (1.f / D) + EPS);
            float z = cb[f] + cw[2 * FF + f] * r0 * P.MWG[(size_t)m * FF + f];
            if (m >= 1) z += cw[FF + f] * rsqrtf(P.MSSQ[m - 1] * (1.f / D) + EPS) * P.MWG[(size_t)(m - 1) * FF + f];
            if (m >= 2) z += cw[f] * rsqrtf(P.MSSQ[m - 2] * (1.f / D) + EPS) * P.MWG[(size_t)(m - 2) * FF + f];
            P.MY[idx] = (bf16_t)f2bf(z * sigm(z) * r0 * P.MWU[(size_t)m * FF + f]);
        }
      } }
    pg8::Gemm g{P.HB, (const bf16_t*)(ws + WS_WU), M, FF, D};
    EpiUp E{(const bf16_t*)(ws + WS_A), (bf16_t*)(ws + WS_Y), P.SSQ, cw, cb, P.MWG, P.MSSQ};
    if constexpr (LAYER == 1) { pg8::PartOrder S; S.init(M, FF, F.G, F.bid); pg8::gemm_phase<EpiUp, pg8::PartOrder, ALIGN_UP, true, true>(F.lds, g, S, E, F.tid); }
    else { UP_ORDER S; S.init(M, FF, F.G, F.bid); pg8::gemm_phase<EpiUp, UP_ORDER, ALIGN_UP, true>(F.lds, g, S, E, F.tid); }
}
template <int LAYER> __device__ __forceinline__ void phase_down(Frame& F, const Args& args, const Ptrs& P) {
    F.refresh(); unsigned char* ws = F.ws;
    auto pre = [&]() { if (LAYER == 0 && F.bid < 64) { side_gemm_wg<true>(F, P.MY, nullptr, (const bf16_t*)(ws + WS_WD), D, FF, P.MW3, F.bid, 64); } };
    pg8::Gemm g{(const bf16_t*)(ws + WS_Y), (const bf16_t*)(ws + WS_WD), M, D, FF}; pg8::StaticOrder S; S.init(M, D, F.G, F.bid);
    EpiRes E{nullptr, LAYER ? args.out : nullptr, P.HB, LAYER ? nullptr : P.SSQ};
    pg8::gemm_phase<EpiRes, pg8::StaticOrder, false, true, false>(F.lds, g, S, E, F.tid, pre);
}

__device__ __forceinline__ void phase_prologue(Frame& F, const Args& args, const Ptrs& P, int gw, int NGW) {
    F.refresh(); unsigned char* ws = F.ws;
    f32x4 vc[4], vn[4];
    if (gw < M + NMETA) row_load4(gw < M ? args.in[I_X] + (size_t)gw * D : args.in[I_META] + (size_t)(gw - M) * D, vc, F.lane);
    conv_matrix<1>(F, args.in[I_FOXWIN], NIN, D, 4 * D, (bf16_t*)(ws + WS_WIN), args.in[I_FOXNORM], gw, NGW);
    for (int i = F.bid * NTHREADS + F.tid; i < D; i += F.G * NTHREADS) ((float*)(ws + MT_LB))[i] = sigm(args.in[I_HGLB][D + i] - args.in[I_HGLB][i]);
    { v4u* K4 = (v4u*)(ws + WS_K); v4u* V4 = (v4u*)(ws + WS_V); constexpr int PERB = KV_META0 * D * 2 / 16, STR = KVROWS * D * 2 / 16;
      for (int i = F.bid * NTHREADS + F.tid; i < NB * PERB; i += F.G * NTHREADS) { const int b = i / PERB, o = i - b * PERB; K4[(size_t)b * STR + o] = (v4u){0u, 0u, 0u, 0u}; V4[(size_t)b * STR + o] = (v4u){0u, 0u, 0u, 0u}; } }
    __syncthreads();
    LAS float* wfl = (LAS float*)F.lds;
    { float wv[32], gv[32];
#pragma unroll
      for (int i = 0; i < 32; ++i) { const int idx = F.tid + NTHREADS * i, kk = idx >> 4, h = idx & 15; wv[i] = args.in[I_FOXWIN][(size_t)kk * NIN + 3 * D + h]; gv[i] = args.in[I_FOXNORM][kk]; }
#pragma unroll
      for (int i = 0; i < 32; ++i) { const int idx = F.tid + NTHREADS * i, kk = idx >> 4, h = idx & 15; const int i4 = kk >> 2, rem = i4 & 127; wfl[h * D + 4 * ((i4 >> 7) * 128 + (rem & 1) * 64 + (rem >> 1)) + (kk & 3)] = gv[i] * wv[i]; } }
    __syncthreads();
    float* LOGF = (float*)(ws + WS_LOGF);
    {
        int r = gw;
        while (r < M + NMETA) {
            const int rn = r + NGW;
            if (rn < M + NMETA) row_load4(rn < M ? args.in[I_X] + (size_t)rn * D : args.in[I_META] + (size_t)(rn - M) * D, vn, F.lane);
            if (r < M) { const int b = r >> 13, i = r & (SEQ - 1);
                row_pass_fl(vc, P.HB + (size_t)r * D, P.SSQ + (size_t)r * 16, nullptr, nullptr, (const LAS f32x4*)wfl, args.in[I_FOXBF],
                            LOGF + (size_t)(b * H + F.lane) * L + NMETA + i, nullptr, F.lane);
            } else { const int m = r - M;
                row_pass_fl(vc, nullptr, nullptr, P.HMA + (size_t)m * D, P.MSSQ + m, (const LAS f32x4*)wfl, args.in[I_FOXBF],
                            LOGF + (size_t)F.lane * L + m, LOGF + (size_t)(H + F.lane) * L + m, F.lane);
            }
#pragma unroll
            for (int j = 0; j < 4; ++j) vc[j] = vn[j];
            r = rn;
        }
    }
    __syncthreads();
}
__device__ __forceinline__ void phase_foxin(Frame& F, const Args& args, const Ptrs& P) {
    F.refresh(); unsigned char* ws = F.ws;
    auto pre = [&]() { side_gemm_wg<false>(F, P.HMA, nullptr, (const bf16_t*)(ws + WS_WIN), 4 * D, D, P.MW, F.bid, F.G); };
    pg8::Gemm g{P.HB, (const bf16_t*)(ws + WS_WIN), M, 4 * D, D}; pg8::StaticOrder S; S.init(M, 4 * D, F.G, F.bid);
    EpiFoxIn E{(bf16_t*)(ws + WS_Q), (bf16_t*)(ws + WS_K), (bf16_t*)(ws + WS_V), (bf16_t*)(ws + WS_GATE), P.SSQ, args.in[I_FOXQG], args.in[I_FOXKG]};
    pg8::gemm_phase<EpiFoxIn, pg8::StaticOrder, ALIGN_IN, true, false>(F.lds, g, S, E, F.tid, pre);
}
__device__ __forceinline__ void phase_scan(Frame& F, const Args& args, const Ptrs& P) {
    F.refresh(); unsigned char* ws = F.ws;
    const float* LOGF = (const float*)(ws + WS_LOGF); float* BIAS = (float*)(ws + WS_BIAS);
    if (F.bid < NB * H) {
        const float* lf = LOGF + (size_t)F.bid * L; float* bo = BIAS + (size_t)F.bid * KVROWS;
        LAS float* wsum = (LAS float*)F.lds;
        constexpr int PER = 17;
        float v[PER]; float s = 0.f;
#pragma unroll
        for (int j = 0; j < PER; ++j) { const int pos = PER * F.tid + j; v[j] = pos < L ? lf[pos] : 0.f; s += v[j]; }
        float incl = s;
#pragma unroll
        for (int o = 1; o < 64; o <<= 1) { const float n = __shfl_up(incl, o); if (F.lane >= o) incl += n; }
        if (F.lane == 63) wsum[F.wave] = incl;
        __syncthreads();
        float pre = 0.f;
        for (int w = 0; w < F.wave; ++w) pre += wsum[w];
        float run = pre + incl - s;
        LAS float* tend = (LAS float*)F.lds + 64; LAS float* tstart = tend + 160;
#pragma unroll
        for (int j = 0; j < PER; ++j) { const int pos = PER * F.tid + j, idx = KV_META0 + pos; run += v[j];
            if (pos < L) { const float bv = -run * LOG2E; bo[idx] = bv; if ((idx & 63) == 63) tend[idx >> 6] = bv; if ((idx & 63) == 0) tstart[idx >> 6] = bv; } }
        for (int r = F.tid; r < KV_META0; r += NTHREADS) bo[r] = BIAS_DUMMY;
        if (F.tid == 0) tend[0] = BIAS_DUMMY;
        asm volatile("s_waitcnt vmcnt(0)" ::: "memory"); __syncthreads();
        const float gqm = wave_max(fabsf(args.in[I_FOXQG][F.lane])), gkm = wave_max(fabsf(args.in[I_FOXKG][F.lane]));
        const float skipc = SKIP_LOG2 + 2.f * (8.f * gqm * gkm * 1.02f * LOG2E);
        if (F.tid < 32) {
            const int qb = F.tid, nchk = 4 * qb + 2; const float lim = tstart[(KV_MAIN0 >> 6) + 4 * qb] - skipc;
            int lo = 0, hi2 = nchk;
            while (lo < hi2) { const int mid = (lo + hi2) >> 1; if (tend[mid] < lim) lo = mid + 1; else hi2 = mid; }
            ((int*)(ws + MT_T0))[F.bid * 32 + qb] = lo & ~1;
        }
    } else if (F.bid > NB * H + 1) {
        const int cgw = (F.bid - NB * H - 2) * NWAVES + F.wave, cngw = (F.G - NB * H - 2) * NWAVES;
        conv_matrix<0>(F, args.in[I_FOXWOUT], D, D, D, (bf16_t*)(ws + WS_WOUT), nullptr, cgw, cngw);
        ffn_convert(F, args, 0, cgw, cngw);
    } else {
        LAS float* qn = (LAS float*)F.lds + F.wave * 2048; LAS float* kn = qn + 1024;
        const int d = F.lane, j = F.lane & 15, dg = F.lane >> 4;
        bf16_t* Kb = (bf16_t*)(ws + WS_K); bf16_t* Vb = (bf16_t*)(ws + WS_V);
        {
            const int h = F.wave + 8 * (F.bid - NB * H);
            const int st = 256 * (h >> 2) + 128 * (d >> 5) + 32 * (h & 3) + (d & 31);
            float qr[NMETA], kr[NMETA], vr[NMETA], gr[NMETA], rsm[NMETA];
            const float gqd = args.in[I_FOXQG][d], gkd = args.in[I_FOXKG][d];
#pragma unroll
            for (int m = 0; m < NMETA; ++m) {
                const float* row = P.MW + (size_t)m * 4 * D;
                qr[m] = row[st]; kr[m] = row[D + st]; vr[m] = row[2 * D + st]; gr[m] = row[3 * D + st]; rsm[m] = rsqrtf(P.MSSQ[m] * (1.f / D) + EPS);
            }
            float cmj = LOGF[(size_t)h * L + j];
            asm volatile("" ::: "memory");
#pragma unroll
            for (int o = 1; o < 16; o <<= 1) { const float n = __shfl_up(cmj, o, 16); if (j >= o) cmj += n; }
#pragma unroll
            for (int m = 0; m < NMETA; ++m) {
                const float rs = rsm[m];
                const float q = rs * qr[m], kk = rs * kr[m];
                const float sq = wave_sum(q * q), sk = wave_sum(kk * kk);
                const float qv = q * rsqrtf(sq * (1.f / HD) + EPS) * gqd * 0.125f, kv = kk * rsqrtf(sk * (1.f / HD) + EPS) * gkd;
                qn[m * 64 + d] = qv; kn[m * 64 + d] = kv; vr[m] = rs * vr[m]; gr[m] = sigm(rs * gr[m]);
#pragma unroll
                for (int b = 0; b < NB; ++b) { const size_t o = ((size_t)b * KVROWS + KV_META0 + m) * D + h * HD + d; Kb[o] = (bf16_t)f2bf(kv); Vb[o] = (bf16_t)f2bf(vr[m]); }
            }
            float pm[NMETA];
#pragma unroll
            for (int m = 0; m < NMETA; ++m) {
                float part = 0.f;
#pragma unroll
                for (int q4 = 0; q4 < 4; ++q4) { const f32x4 qa = *(const LAS f32x4*)(qn + m * 64 + 16 * dg + 4 * q4), ka = *(const LAS f32x4*)(kn + j * 64 + 16 * dg + 4 * q4); part += (qa.x * ka.x + qa.y * ka.y) + (qa.z * ka.z + qa.w * ka.w); }
                part += __shfl_xor(part, 16); part += __shfl_xor(part, 32);
                const float cmm = __shfl(cmj, m);
                const float sc = (j <= m) ? part + cmm - cmj : -INFINITY;
                const float mx = row16_max(sc);
                const float p = (j <= m) ? __expf(sc - mx) : 0.f; const float l = row16_sum(p);
                pm[m] = p * __builtin_amdgcn_rcpf(l);
            }
#pragma unroll
            for (int m = 0; m < NMETA; ++m) {
                float o = 0.f;
#pragma unroll
                for (int jj = 0; jj < NMETA; ++jj) if (jj <= m) o += __shfl(pm[m], jj) * vr[jj];
                P.MA[(size_t)m * D + h * HD + d] = (bf16_t)f2bf(o * gr[m]);
            }
        }
    }
}
__device__ __forceinline__ void phase_attn(Frame& F, const Args& args, const Ptrs& P, unsigned char* lds_generic) {
    F.refresh(); unsigned char* ws = F.ws;
    if (F.bid < 64) side_gemm_wg<true>(F, P.MA, nullptr, (const bf16_t*)(ws + WS_WOUT), D, D, P.MW2, F.bid, 64);
    const float gqm = wave_max(fabsf(args.in[I_FOXQG][F.lane])), gkm = wave_max(fabsf(args.in[I_FOXKG][F.lane]));
    const float smax2 = 8.f * gqm * gkm * 1.02f * LOG2E;
    const float skipc = SKIP_LOG2 + 2.f * smax2;
    const attn_body::AttnTensors AT{(const attn_body::bf16*)(ws + WS_Q), (const attn_body::bf16*)(ws + WS_K), (const attn_body::bf16*)(ws + WS_V), (attn_body::bf16*)(ws + WS_Q),
                                    (const float*)(ws + WS_BIAS), (const attn_body::bf16*)(ws + WS_GATE), skipc, (const int*)(ws + MT_T0)};
    const attn_body::StaticOrder S((int)F.G, (int)F.bid);
    attn_body::attn_phase<attn_body::StaticOrder, ATTN_THRL>((char*)lds_generic, AT, S, F.tid);
}
__device__ __forceinline__ void phase_foxout(Frame& F, const Args& args, const Ptrs& P) {
    F.refresh(); unsigned char* ws = F.ws;
    pg8::Gemm g{(const bf16_t*)(ws + WS_Q), (const bf16_t*)(ws + WS_WOUT), M, D, D}; pg8::StaticOrder S; S.init(M, D, F.G, F.bid);
    EpiRes E{FOXOUT_BASE, nullptr, P.HB, P.SSQ};
    pg8::gemm_phase<EpiRes, pg8::StaticOrder, false, true>(F.lds, g, S, E, F.tid);
}

__device__ __forceinline__ void hg_convert(Frame& F, const Args& args, int gw, int NGW) {
    conv_matrix<0>(F, args.in[I_HGWIN], 4 * D, D, 4 * D, (bf16_t*)(F.ws + WS_WIN), args.in[I_HGNORM], gw, NGW);
    conv_matrix<0>(F, args.in[I_HGWOUT], D, D, D, (bf16_t*)(F.ws + WS_WOUT), nullptr, gw, NGW);
}
__device__ __forceinline__ void phase_hgin(Frame& F, const Args& args, const Ptrs& P) {
    F.refresh(); unsigned char* ws = F.ws;
    auto pre = [&]() { side_gemm_wg<false>(F, P.HMB, P.MW3, (const bf16_t*)(ws + WS_WIN), 4 * D, D, P.MW, F.bid, F.G); };
    if (F.bid == F.G - 1) meta_consolidate(P.HMB, P.MW3, P.HMA, P.MSSQ, F.wave, F.lane);
    pg8::Gemm g{P.HB, (const bf16_t*)(ws + WS_WIN), M, 4 * D, D}; pg8::StaticOrder S; S.init(M, 4 * D, F.G, F.bid);
    EpiHgIn E{(bf16_t*)(ws + WS_QH), (bf16_t*)(ws + WS_VH), (bf16_t*)(ws + WS_G), (_Float16*)(ws + WS_LF), P.SSQ, (const float*)(ws + MT_LB)};
    pre(); __syncthreads();
    pg8::gemm_phase<EpiHgIn, pg8::StaticOrder, ALIGN_IN, true>(F.lds, g, S, E, F.tid);
}
__device__ __forceinline__ hg::UnitCtx hg_ctx(Frame& F, const Args& args, const Ptrs& P) {
    unsigned char* ws = F.ws;
    return hg::UnitCtx{(const bf16_t*)(ws + WS_QH), (const _Float16*)(ws + WS_LF), (const bf16_t*)(ws + WS_VH), (const bf16_t*)(ws + WS_G), (bf16_t*)(ws + WS_QH), P.MW, P.MSSQ, (const float*)(ws + MT_LB), args.in[I_HGOG], P.MA};
}
__device__ __forceinline__ void phase_hg1(Frame& F, const Args& args, const Ptrs& P) {
    F.refresh(); const hg::UnitCtx C = hg_ctx(F, args, P);
    for (int i = 0, base = 0; base < NB * HH * hg::NSC; ++i, base += F.G) { const int u = base + (F.bid + 16 * i) % F.G;
        if (u < NB * HH * hg::NSC) hg::unit<false>(F, C, u, (float*)args.out, (float*)(F.ws + WS_HDEC)); }
}
__device__ __forceinline__ void phase_hg2(Frame& F, const Args& args, const Ptrs& P) {
    F.refresh();
#ifndef TEST_BUILD
    ffn_convert(F, args, 1, F.bid * NWAVES + F.wave, F.G * NWAVES);
#endif
    hg::scan(F, (float*)args.out, (const float*)(F.ws + WS_HDEC));
}
__device__ __forceinline__ void phase_hg3(Frame& F, const Args& args, const Ptrs& P) {
    F.refresh(); const hg::UnitCtx C = hg_ctx(F, args, P);
    for (int i = 0, base = 0; base < NB * HH * hg::NSC; ++i, base += F.G) { const int u = base + (F.bid + 16 * i) % F.G;
        if (u < NB * HH * hg::NSC) hg::unit<true>(F, C, u, (float*)args.out, (float*)(F.ws + WS_HDEC)); }
}
__device__ __forceinline__ void phase_hgout(Frame& F, const Args& args, const Ptrs& P) {
    F.refresh(); unsigned char* ws = F.ws;
    auto pre = [&]() { if (F.bid < 64) side_gemm_wg<true>(F, P.MA, nullptr, (const bf16_t*)(ws + WS_WOUT), D, D, P.MW2, F.bid, 64); };
    pg8::Gemm g{(const bf16_t*)(ws + WS_QH), (const bf16_t*)(ws + WS_WOUT), M, D, D}; pg8::StaticOrder S; S.init(M, D, F.G, F.bid);
    EpiRes E{nullptr, nullptr, P.HB, P.SSQ};
    pg8::gemm_phase<EpiRes, pg8::StaticOrder, false, true, false>(F.lds, g, S, E, F.tid, pre);
}

__global__ void __launch_bounds__(NTHREADS, 2) mk_fwd(Args args) {
    extern __shared__ __attribute__((aligned(16))) unsigned char lds_raw[];
    Frame F;
    F.lds = (LAS unsigned char*)lds_raw; F.wave = __builtin_amdgcn_readfirstlane((int)threadIdx.x >> 6); F.refresh();
    F.G = gridDim.x; F.bid = blockIdx.x; F.ws = args.ws;
    unsigned char* ws = args.ws;
    const int gw = F.bid * NWAVES + F.wave, NGW = F.G * NWAVES;
    Ptrs P;
    P.SSQ = (float*)(ws + WS_SSQ); P.HB = (bf16_t*)(ws + WS_HB);
    P.HMA = (float*)(ws + MT_HMA); P.HMB = (float*)(ws + MT_HMB); P.MW = (float*)(ws + MT_MW); P.MW2 = (float*)(ws + MT_MW2); P.MW3 = (float*)(ws + MT_MW3);
    P.MWG = (float*)(ws + MT_MWG); P.MWU = (float*)(ws + MT_MWU); P.MSSQ = (float*)(ws + MT_MSSQ); P.MY = (bf16_t*)(ws + MT_MY); P.MA = (bf16_t*)(ws + MT_MA);
    const int lo = args.ph_lo, hi = args.ph_hi;
#define IN(k) (lo <= (k) && (k) < hi)
#ifdef TEST_BUILD
    if (IN(PH_T_FFNPREP0) || IN(PH_T_FFNPREP1)) {
        F.refresh();
        ffn_convert(F, args, IN(PH_T_FFNPREP1) ? 1 : 0, gw, NGW);
        for (int r = gw; r < M; r += NGW) row_to_bf16(args.out + (size_t)r * D, P.HB + (size_t)r * D, P.SSQ + (size_t)r * 16, F.lane);
        const float* nhm = (const float*)(ws + WS_NHM);
        for (int i = F.bid * NTHREADS + F.tid; i < NMETA * D; i += F.G * NTHREADS) { P.HMA[i] = nhm[i]; P.MW2[i] = 0.f; }
    }
#endif
#ifdef TEST_BUILD
    if (IN(PH_T_FFNPOST)) {
        F.refresh();
        float* nhm = (float*)(ws + WS_NHM);
        for (int i = F.bid * NTHREADS + F.tid; i < NMETA * D; i += F.G * NTHREADS) { const float v = P.HMB[i] + P.MW3[i]; nhm[i] = v; nhm[NMETA * D + i] = v; }
    }
#endif
#ifdef TEST_BUILD
    if (IN(PH_T_FOXPOST)) {
        F.refresh();
        float* nhm = (float*)(ws + WS_NHM);
        for (int i = F.bid * NTHREADS + F.tid; i < NMETA * D; i += F.G * NTHREADS) { const float v = P.HMA[i] + P.MW2[i]; nhm[i] = v; nhm[NMETA * D + i] = v; }
    }
#endif
    volatile LAS unsigned* MISC = (volatile LAS unsigned*)(F.lds + LDS_BYTES - 256);
    XcdBarrier bar; bar.bar = (unsigned*)(ws + WS_CTL) + 4096; bar.x = 0; bar.st = nullptr;
    const bool multi = (hi - lo > 1) && hi <= NPH;
    if (multi) { if (F.tid < 64) MISC[F.tid] = 0u; __syncthreads(); bar = xcd_barrier_post((unsigned*)(ws + WS_CTL) + 4096, MISC + 8, F.tid == 0); }
#ifdef ECHO_PH
#define PHASE(k, call) do { if (IN(k)) { const unsigned long long e0_ = __builtin_amdgcn_s_memrealtime(); call; if ((k) == ECHO_PH) { const unsigned long long e1_ = __builtin_amdgcn_s_memrealtime(), ed_ = e1_ - e0_; while (__builtin_amdgcn_s_memrealtime() - e1_ < ed_) __builtin_amdgcn_s_sleep(4); } } } while (0)
#else
#define PHASE(k, call) do { if (IN(k)) { call; } } while (0)
#endif
#define SEAM(k) do { if (IN(k) && IN((k) + 1)) { F.refresh(); xcd_barrier(bar, F.tid == 0); } } while (0)
    PHASE(PH_PRO, phase_prologue(F, args, P, gw, NGW));
    SEAM(PH_PRO);
    PHASE(PH_FOXIN, phase_foxin(F, args, P));
    SEAM(PH_FOXIN);
    PHASE(PH_SCAN, phase_scan(F, args, P));
    SEAM(PH_SCAN);
    PHASE(PH_ATTN, phase_attn(F, args, P, lds_raw));
    SEAM(PH_ATTN);
    PHASE(PH_FOXOUT, phase_foxout(F, args, P));
    SEAM(PH_FOXOUT);
    PHASE(PH_GATE0, phase_gate<0>(F, args, P));
    SEAM(PH_GATE0);
    PHASE(PH_UP0, phase_up<0>(F, args, P));
    SEAM(PH_UP0);
    PHASE(PH_DOWN0, phase_down<0>(F, args, P));
    SEAM(PH_DOWN0);
#ifdef TEST_BUILD
    if (IN(PH_T_HGPREP)) {
        F.refresh(); hg_convert(F, args, gw, NGW);
        for (int i = F.bid * NTHREADS + F.tid; i < D; i += F.G * NTHREADS) ((float*)(ws + MT_LB))[i] = sigm(args.in[I_HGLB][D + i] - args.in[I_HGLB][i]);
        for (int r = gw; r < M; r += NGW) row_to_bf16(args.out + (size_t)r * D, P.HB + (size_t)r * D, P.SSQ + (size_t)r * 16, F.lane);
        const float* nhm = (const float*)(ws + WS_NHM);
        for (int i = F.bid * NTHREADS + F.tid; i < NMETA * D; i += F.G * NTHREADS) { P.HMB[i] = nhm[i]; P.MW3[i] = 0.f; }
    }
#endif
    PHASE(PH_HGIN, phase_hgin(F, args, P));
    SEAM(PH_HGIN);
    PHASE(PH_HG1, phase_hg1(F, args, P));
    SEAM(PH_HG1);
    PHASE(PH_HG2, phase_hg2(F, args, P));
    SEAM(PH_HG2);
    PHASE(PH_HG3, phase_hg3(F, args, P));
    SEAM(PH_HG3);
    PHASE(PH_HGOUT, phase_hgout(F, args, P));
    SEAM(PH_HGOUT);
#ifdef TEST_BUILD
    if (IN(PH_T_HGPOST)) {
        F.refresh(); float* nhm = (float*)(ws + WS_NHM);
        for (int i = F.bid * NTHREADS + F.tid; i < NMETA * D; i += F.G * NTHREADS) { const float v = P.HMA[i] + P.MW2[i]; nhm[i] = v; nhm[NMETA * D + i] = v; }
    }
#endif
    PHASE(PH_GATE1, phase_gate<1>(F, args, P));
    SEAM(PH_GATE1);
    PHASE(PH_UP1, phase_up<1>(F, args, P));
    SEAM(PH_UP1);
    PHASE(PH_DOWN1, phase_down<1>(F, args, P));
}

#ifndef N_LAUNCH_PER_PHASE
#define N_LAUNCH_PER_PHASE 0
#endif
extern "C" void kernel_launch(void* const* d_in, const int* in_sizes, int n_in, void* d_out, int out_size, void* d_ws, size_t ws_size, hipStream_t stream) {
    static int grid = 0;
    if (grid == 0) {
        if (n_in != 19 || out_size != M * D || ws_size < WS_END) { fprintf(stderr, "kernel_launch: unexpected problem shape (n_in %d, out %d, ws %zu); nothing launched\n", n_in, out_size, ws_size); grid = -1; return; }
        int dev = 0, cus = 0, per_cu = 0;
        if (hipGetDevice(&dev) != hipSuccess || hipDeviceGetAttribute(&cus, hipDeviceAttributeMultiprocessorCount, dev) != hipSuccess) { grid = -1; return; }
        if (hipFuncSetAttribute((const void*)mk_fwd, hipFuncAttributeMaxDynamicSharedMemorySize, LDS_BYTES) != hipSuccess) { fprintf(stderr, "kernel_launch: hipFuncSetAttribute failed\n"); grid = -1; return; }
        if (hipOccupancyMaxActiveBlocksPerMultiprocessor(&per_cu, (const void*)mk_fwd, NTHREADS, LDS_BYTES) != hipSuccess || per_cu < 1) { fprintf(stderr, "kernel_launch: occupancy query reports %d workgroups per CU; nothing launched\n", per_cu); (void)hipGetLastError(); grid = -1; return; }
        grid = cus;
        if (grid != 256) fprintf(stderr, "kernel_launch: this kernel's static unit orders are built for 256 CUs; got %d\n", grid);
    }
    if (grid < 0) return;
    if (hipMemsetAsync((char*)d_ws + WS_CTL, 0, CTL_ZERO_BYTES, stream) != hipSuccess) return;
    Args a{};
    for (int i = 0; i < 19; ++i) a.in[i] = (const float*)d_in[i];
    a.out = (float*)d_out; a.ws = (unsigned char*)d_ws;
    if (N_LAUNCH_PER_PHASE) {
        for (int ph = 0; ph < NPH; ++ph) { a.ph_lo = ph; a.ph_hi = ph + 1; hipLaunchKernelGGL(mk_fwd, dim3(grid), dim3(NTHREADS), LDS_BYTES, stream, a); }
    } else {
        a.ph_lo = 0; a.ph_hi = NPH;
        hipLaunchKernelGGL(mk_fwd, dim3(grid), dim3(NTHREADS), LDS_BYTES, stream, a);
    }
}
```

```cpp
#include <hip/hip_runtime.h>
#include <hip/hip_bf16.h>
#include <cstdint>
#include <cstdio>
#include <cmath>

constexpr int NB = 2, SEQ = 8192, NMETA = 16, L = SEQ + NMETA, D = 1024, H = 16, HD = 64, FF = 2816, HH = 8, DK = 128;
constexpr int M = NB * SEQ;
constexpr int NIN = 4 * D + H;
constexpr int KVROWS = 8320, KV_META0 = 112, KV_MAIN0 = 128;
constexpr float EPS = 1e-6f;
constexpr float LOG2E = 1.4426950408889634f;
constexpr float C2 = 0.125f * LOG2E;
constexpr float BIAS_DUMMY = -1000.f;

constexpr size_t MiB = 1u << 20, KiB = 1u << 10;
constexpr size_t WS_CTL = 0, CTL_ZERO_BYTES = 1 * MiB;
constexpr size_t WS_SSQ = 1 * MiB;
constexpr size_t WS_LOGF = 2 * MiB;
constexpr size_t WS_BIAS = 3 * MiB + 256 * KiB;
constexpr size_t WS_META = 4 * MiB + 512 * KiB;
constexpr size_t MT_HMA = WS_META, MT_HMB = WS_META + 64 * KiB, MT_MW = WS_META + 128 * KiB, MT_MW2 = WS_META + 384 * KiB, MT_MWG = WS_META + 448 * KiB,
                 MT_MWU = WS_META + 624 * KiB, MT_MW3 = WS_META + 800 * KiB, MT_MA = WS_META + 864 * KiB, MT_MY = WS_META + 896 * KiB, MT_MSSQ = WS_META + 984 * KiB, MT_LB = WS_META + 992 * KiB, MT_T0 = WS_META + 996 * KiB;
constexpr size_t WS_HDEC = 5 * MiB + 512 * KiB;
constexpr size_t WS_NHM = 6 * MiB;
constexpr size_t WS_HB = 8 * MiB;
constexpr size_t WS_WG = 40 * MiB, WS_WU = WS_WG + (size_t)FF * D * 2, WS_WD = WS_WU + (size_t)FF * D * 2;
constexpr size_t WS_WIN = 57 * MiB, WS_WOUT = 65 * MiB;
constexpr size_t WS_A = 67 * MiB, WS_Y = 155 * MiB;
constexpr size_t WS_Q = 67 * MiB, WS_K = 99 * MiB, WS_V = 132 * MiB, WS_GATE = 165 * MiB;
constexpr size_t WS_QH = 67 * MiB, WS_VH = 99 * MiB, WS_G = 131 * MiB, WS_LF = 163 * MiB, WS_ST = WS_HB;
constexpr size_t WS_END = 256 * MiB;
static_assert(WS_Y + (size_t)M * FF * 2 <= WS_END && WS_WD + (size_t)FF * D * 2 <= WS_WIN && WS_LF + (size_t)M * D * 4 <= WS_END, "ws map");
static_assert(WS_VH == WS_QH + (size_t)M * D * 2 && WS_G == WS_VH + (size_t)M * D * 2, "EpiHgIn addresses QH | VH | G by offset");
static_assert(WS_K + (size_t)NB * KVROWS * D * 2 <= WS_V && WS_V + (size_t)NB * KVROWS * D * 2 <= WS_GATE, "ws map kv");

typedef unsigned short bf16_t;
namespace pg8 {
#define PG8_LAS __attribute__((address_space(3)))
typedef unsigned short bf16_t;
typedef short bf16x8 __attribute__((ext_vector_type(8)));
typedef float f32x4 __attribute__((ext_vector_type(4)));
typedef unsigned u32x4 __attribute__((ext_vector_type(4)));
constexpr int BM = 256, BK = 64, HALF = 128, HTB = HALF * BK * 2  , STAGE_BYTES = 8 * HTB, NXCD = 8, WGM = 8;

__host__ __device__ __forceinline__ int lds_byte(int r, int c) { const int st = (r >> 4) * 2 + (c >> 5), rr = r & 15, cc = c & 31, ob = rr * 64 + cc * 2; return st * 1024 + (ob ^ (((ob >> 9) & 1) << 5)); }
__host__ __device__ __forceinline__ void stage_rc(int b, int& R, int& C) { const int st = b / 1024, sb = b % 1024, swz = sb ^ (((sb >> 9) & 1) << 5); R = (st >> 1) * 16 + swz / 64; C = (st & 1) * 32 + (swz % 64) / 2; }
__host__ __device__ __forceinline__ int perm32(int rho) { const int n = rho >> 4, i = rho & 15; return 8 * (i >> 2) + 4 * n + (i & 3); }

struct Unit { int pm, pn, r0, c0, part; };
struct Gemm { const bf16_t* A; const bf16_t* Bt; int M, N, K; };

struct StaticOrder {
    int nM, nN, nwg, G, c;
    __host__ __device__ void init(int M, int N, int G_, int c_) { nM = M / BM; nN = N / BM; nwg = nM * nN; G = G_; c = c_; }
    __host__ __device__ bool next(int i, Unit& u) const {
        const long L = (long)i * G + c; if (L >= nwg) return false;
        int wgid = (int)L; { const int q = nwg / NXCD, r = nwg % NXCD, xcd = wgid % NXCD, off = wgid / NXCD; wgid = (xcd < r ? xcd * (q + 1) : r * (q + 1) + (xcd - r) * q) + off; }
        const int nig = WGM * nN, gid = wgid / nig, fm = gid * WGM, gsz = (nM - fm) < WGM ? (nM - fm) : WGM;
        u.pm = fm + ((wgid % nig) % gsz); u.pn = (wgid % nig) / gsz; u.r0 = u.pm * BM; u.c0 = u.pn * BM; u.part = 0; return true;
    }
    __device__ __forceinline__ void a_ready(const Unit&) const {}
    __device__ __forceinline__ void done(const Unit&) const {}
};

struct NoPre { __device__ __forceinline__ void operator()() const {} };
struct PartOrder : StaticOrder {
    __host__ __device__ bool next(int i, Unit& u) const {
        if (G != 256 || nM != 64 || nN != 11) return StaticOrder::next(i, u);
        if (i >= 3) return false;
        const int xcd = c & 7, off = c >> 3;
        if (i < 2) { const int o = i * 32 + off; u.pm = 8 * xcd + (o & 7); u.pn = o >> 3; u.r0 = u.pm * BM; u.c0 = u.pn * BM; u.part = 0; }
        else { u.r0 = 8 * xcd * BM + HALF * (off & 15); u.c0 = 8 * BM + 3 * HALF * (off >> 4); u.pm = u.r0 / BM; u.pn = 8; u.part = 1; }
        return true;
    }
};

__device__ __forceinline__ unsigned cvt_pk_bf16(float lo, float hi) { unsigned r; asm volatile("v_cvt_pk_bf16_f32 %0, %1, %2" : "=v"(r) : "v"(lo), "v"(hi)); return r; }
typedef float f32x2 __attribute__((ext_vector_type(2)));
template <class Epi, class Sched, bool ALIGN_EPI = false, bool SP2 = false, bool HASPART = false, class Pre = NoPre>
__device__ __forceinline__ void gemm_phase(PG8_LAS unsigned char* lds, const Gemm g, const Sched& S, const Epi& E, const int tid_in, const Pre& pre = Pre()) {
    const int tid = tid_in, wid = __builtin_amdgcn_readfirstlane(tid >> 6), lane = tid & 63, wr = wid >> 2, wc = wid & 3, fr = lane & 15, fq = lane >> 4;
    const int K = g.K, nt = K / BK;
    unsigned voffA[2], voffB[2];
#pragma unroll
    for (int i = 0; i < 2; ++i) { int R, C; stage_rc(tid * 16 + i * 8192, R, C); const int Rb = Epi::PERM ? ((R & ~31) + perm32(R & 31)) : R;
        voffA[i] = (unsigned)(R * K + C) * 2u; voffB[i] = (unsigned)(Rb * K + C) * 2u; }
    const size_t kstep = (size_t)(BK * 2);
    const size_t hstep = (size_t)HALF * K * 2;
    const size_t rstep = (size_t)K * 2;
    static_assert(SP2 || !HASPART, "part units need the two-super-phase loop");
    const unsigned ldsw = (unsigned)wid * 1024u;
    const int aoff = lds_byte(wr * 64 + fr, fq * 8), boff = lds_byte(wc * 32 + fr, fq * 8);
#define PG8_SA(b, h) (((b) * 2 + (h)) * HTB)
#define PG8_SB(b, h) ((4 + (b) * 2 + (h)) * HTB)
#define PG8_STAGE(bufoff, gbase, voff) do { _Pragma("unroll") for (int _i = 0; _i < 2; ++_i) \
        __builtin_amdgcn_global_load_lds((const unsigned*)((const char*)(gbase) + (voff)[_i]), (PG8_LAS unsigned*)(lds + (bufoff) + ldsw + _i * 8192), 16, 0, 0); } while (0)
#define PG8_LDA(dst, b, h) do { _Pragma("unroll") for (int m = 0; m < 4; ++m) _Pragma("unroll") for (int k = 0; k < 2; ++k) dst[m][k] = *(const PG8_LAS bf16x8*)(lds + PG8_SA(b, h) + aoff + m * 2048 + k * 1024); } while (0)
#define PG8_LDBX(dst, off) do { _Pragma("unroll") for (int n = 0; n < 2; ++n) _Pragma("unroll") for (int k = 0; k < 2; ++k) dst[n][k] = *(const PG8_LAS bf16x8*)(lds + (off) + boff + n * 2048 + k * 1024); } while (0)
#define PG8_LDB(dst, b, h) do { _Pragma("unroll") for (int n = 0; n < 2; ++n) _Pragma("unroll") for (int k = 0; k < 2; ++k) dst[n][k] = *(const PG8_LAS bf16x8*)(lds + PG8_SB(b, h) + boff + n * 2048 + k * 1024); } while (0)
#define PG8_MMA(ai, bj, At, Bt) do { __builtin_amdgcn_s_setprio(1); _Pragma("unroll") for (int m = 0; m < 4; ++m) _Pragma("unroll") for (int n = 0; n < 2; ++n) _Pragma("unroll") for (int k = 0; k < 2; ++k) \
        acc[ai][bj][m][n] = __builtin_amdgcn_mfma_f32_16x16x32_bf16(Bt[n][k], At[m][k], acc[ai][bj][m][n], 0, 0, 0); __builtin_amdgcn_s_setprio(0); } while (0)
#define PG8_WAIT_V(n) asm volatile("s_waitcnt vmcnt(" #n ")" ::: "memory")
#define PG8_WAIT_L(n) asm volatile("s_waitcnt lgkmcnt(" #n ")" ::: "memory")
#define PG8_BAR __builtin_amdgcn_s_barrier()
#define PG8_SCHED __builtin_amdgcn_sched_barrier(0)
    Unit cur, nxt; int ui = 0;
    if (!S.next(0, cur)) return;
    bf16x8 At[4][2], B0[2][2], B1[2][2];
    const char* cA = (const char*)g.A + (size_t)cur.r0 * rstep; const char* cB = (const char*)g.Bt + (size_t)cur.c0 * rstep;
    S.a_ready(cur);
    if constexpr (SP2) {
        PG8_STAGE(PG8_SB(0, 0), cB, voffB); PG8_STAGE(PG8_SB(0, 1), cB + hstep, voffB); PG8_STAGE(PG8_SA(0, 0), cA, voffA); PG8_STAGE(PG8_SA(0, 1), cA + hstep, voffA);
        pre();
        if (wr == 1) PG8_BAR;
        PG8_WAIT_V(2); PG8_BAR;
        PG8_STAGE(PG8_SB(1, 0), cB + kstep, voffB); PG8_STAGE(PG8_SA(1, 0), cA + kstep, voffA); PG8_STAGE(PG8_SB(1, 1), cB + hstep + kstep, voffB);
        PG8_WAIT_V(6); PG8_BAR;
    } else {
        PG8_STAGE(PG8_SB(0, 0), cB, voffB); PG8_STAGE(PG8_SA(0, 0), cA, voffA); PG8_STAGE(PG8_SB(0, 1), cB + hstep, voffB); PG8_STAGE(PG8_SA(0, 1), cA + hstep, voffA);
        if (wr == 1) PG8_BAR;
        PG8_WAIT_V(4); PG8_BAR;
        PG8_STAGE(PG8_SB(1, 0), cB + kstep, voffB); PG8_STAGE(PG8_SA(1, 0), cA + kstep, voffA); PG8_STAGE(PG8_SB(1, 1), cB + hstep + kstep, voffB);
        PG8_WAIT_V(6); PG8_BAR;
    }
    f32x4 acc[2][2][4][2];
#pragma unroll
    for (int a = 0; a < 2; ++a)
#pragma unroll
        for (int b = 0; b < 2; ++b)
#pragma unroll
            for (int m = 0; m < 4; ++m)
#pragma unroll
                for (int n = 0; n < 2; ++n) acc[a][b][m][n] = (f32x4){0.f, 0.f, 0.f, 0.f};
    for (;;) {
        const bool has_next = S.next(ui + 1, nxt);
        const char* nA = has_next ? (const char*)g.A + (size_t)nxt.r0 * rstep : cA; const char* nB = has_next ? (const char*)g.Bt + (size_t)nxt.c0 * rstep : cB;
        const bool npart = HASPART && has_next && nxt.part != 0;
        if (HASPART && cur.part) {
        for (int t = 0; t < nt; t += 2) {
            const bool last = (t == nt - 2);
            const char* b1 = cB + (size_t)(t + 1) * kstep;
            const char* a2 = last ? nA : cA + (size_t)(t + 2) * kstep; const char* b2 = last ? nB : cB + (size_t)(t + 2) * kstep;
            const char* a3 = a2 + kstep; const char* b3 = b2 + kstep;
            PG8_LDB(B0, 0, 0); PG8_LDB(B1, 0, 1); PG8_SCHED; PG8_LDA(At, 0, 0); PG8_STAGE(PG8_SA(1, 1), b1 + 2 * hstep, voffB);
            PG8_WAIT_V(8); PG8_WAIT_L(0); PG8_BAR; PG8_MMA(0, 0, At, B0); PG8_MMA(0, 1, At, B1); PG8_BAR; PG8_SCHED;
            PG8_LDBX(B0, PG8_SA(0, 1)); PG8_STAGE(PG8_SB(0, 0), b2, voffB); PG8_STAGE(PG8_SB(0, 1), b2 + hstep, voffB); PG8_STAGE(PG8_SA(0, 0), a2, voffA);
            PG8_WAIT_V(8); PG8_WAIT_L(0); PG8_BAR; PG8_MMA(1, 0, At, B0); PG8_BAR; PG8_SCHED;
            PG8_LDB(B0, 1, 0); PG8_LDB(B1, 1, 1); PG8_SCHED; PG8_LDA(At, 1, 0); PG8_STAGE(PG8_SA(0, 1), b2 + 2 * hstep, voffB);
            PG8_WAIT_V(8); PG8_WAIT_L(0); PG8_BAR; PG8_MMA(0, 0, At, B0); PG8_MMA(0, 1, At, B1); PG8_BAR; PG8_SCHED;
            PG8_LDBX(B0, PG8_SA(1, 1)); PG8_STAGE(PG8_SB(1, 0), b3, voffB); PG8_STAGE(PG8_SB(1, 1), b3 + hstep, voffB); PG8_STAGE(PG8_SA(1, 0), a3, voffA);
            PG8_WAIT_V(8); PG8_WAIT_L(0); PG8_BAR; PG8_MMA(1, 0, At, B0); PG8_BAR; PG8_SCHED;
        }
        } else
        for (int t = 0; t < nt; t += 2) {
            const bool last = (t == nt - 2);
            const char* a1 = cA + (size_t)(t + 1) * kstep;
            const char* a2 = last ? nA : cA + (size_t)(t + 2) * kstep; const char* b2 = last ? nB : cB + (size_t)(t + 2) * kstep;
            const char* a3 = a2 + kstep; const char* b3 = b2 + kstep;
            if (last && has_next) S.a_ready(nxt);
            if constexpr (SP2) {
            PG8_LDB(B0, 0, 0); PG8_LDB(B1, 0, 1); PG8_SCHED; PG8_LDA(At, 0, 0); PG8_STAGE(PG8_SA(1, 1), a1 + hstep, voffA);
            PG8_WAIT_V(8); PG8_WAIT_L(0); PG8_BAR; PG8_MMA(0, 0, At, B0); PG8_MMA(0, 1, At, B1); PG8_BAR; PG8_SCHED;
            PG8_LDA(At, 0, 1); PG8_STAGE(PG8_SB(0, 0), b2, voffB); PG8_STAGE(PG8_SB(0, 1), b2 + hstep, voffB); PG8_STAGE(PG8_SA(0, 0), a2, voffA);
            PG8_WAIT_V(8); PG8_WAIT_L(0); PG8_BAR; PG8_MMA(1, 0, At, B0); PG8_MMA(1, 1, At, B1); PG8_BAR; PG8_SCHED;
            PG8_LDB(B0, 1, 0); PG8_LDB(B1, 1, 1); PG8_SCHED; PG8_LDA(At, 1, 0);
            if constexpr (HASPART) { const bool sw = last && npart;
                const char* p01 = sw ? nB + 2 * hstep : a2 + hstep; const unsigned vo[2] = {sw ? voffB[0] : voffA[0], sw ? voffB[1] : voffA[1]}; PG8_STAGE(PG8_SA(0, 1), p01, vo); }
            else PG8_STAGE(PG8_SA(0, 1), a2 + hstep, voffA);
            PG8_WAIT_V(8); PG8_WAIT_L(0); PG8_BAR; PG8_MMA(0, 0, At, B0); PG8_MMA(0, 1, At, B1); PG8_BAR; PG8_SCHED;
            PG8_LDA(At, 1, 1); PG8_STAGE(PG8_SB(1, 0), b3, voffB); PG8_STAGE(PG8_SB(1, 1), b3 + hstep, voffB); PG8_STAGE(PG8_SA(1, 0), a3, voffA);
            PG8_WAIT_V(8); PG8_WAIT_L(0); PG8_BAR; PG8_MMA(1, 0, At, B0); PG8_MMA(1, 1, At, B1); PG8_BAR; PG8_SCHED;
            } else {
            PG8_LDB(B0, 0, 0); PG8_SCHED; PG8_LDA(At, 0, 0); PG8_STAGE(PG8_SA(1, 1), a1 + hstep, voffA);
            PG8_WAIT_L(8); PG8_BAR; PG8_WAIT_L(0); PG8_MMA(0, 0, At, B0); PG8_BAR; PG8_SCHED;
            PG8_LDB(B1, 0, 1); PG8_STAGE(PG8_SB(0, 0), b2, voffB);
            PG8_BAR; PG8_WAIT_L(0); PG8_MMA(0, 1, At, B1); PG8_BAR;
            PG8_LDA(At, 0, 1); PG8_STAGE(PG8_SA(0, 0), a2, voffA);
            PG8_BAR; PG8_WAIT_L(0); PG8_MMA(1, 0, At, B0); PG8_BAR; PG8_SCHED;
            PG8_STAGE(PG8_SB(0, 1), b2 + hstep, voffB);
            PG8_WAIT_V(6); PG8_BAR; PG8_MMA(1, 1, At, B1); PG8_BAR;
            PG8_LDB(B0, 1, 0); PG8_SCHED; PG8_LDA(At, 1, 0); PG8_STAGE(PG8_SA(0, 1), a2 + hstep, voffA);
            PG8_WAIT_L(8); PG8_BAR; PG8_WAIT_L(0); PG8_MMA(0, 0, At, B0); PG8_BAR; PG8_SCHED;
            PG8_LDB(B1, 1, 1); PG8_STAGE(PG8_SB(1, 0), b3, voffB);
            PG8_BAR; PG8_WAIT_L(0); PG8_MMA(0, 1, At, B1); PG8_BAR;
            PG8_LDA(At, 1, 1); PG8_STAGE(PG8_SA(1, 0), a3, voffA);
            PG8_BAR; PG8_WAIT_L(0); PG8_MMA(1, 0, At, B0); PG8_BAR; PG8_SCHED;
            PG8_STAGE(PG8_SB(1, 1), b3 + hstep, voffB);
            PG8_WAIT_V(6); PG8_BAR; PG8_MMA(1, 1, At, B1); PG8_BAR;
            }
        }
        if constexpr (ALIGN_EPI) { if (wr == 0) PG8_BAR; }
        if constexpr (!Epi::AFTER_DRAIN) {
            if constexpr (HASPART) { if (cur.part) E.part(acc, cur, wr, wc, fr, fq); else E(acc, cur, wr, wc, fr, fq); }
            else E(acc, cur, wr, wc, fr, fq);
            S.done(cur); }
        if (!has_next) break;
#pragma unroll
        for (int a = 0; a < 2; ++a)
#pragma unroll
            for (int b = 0; b < 2; ++b)
#pragma unroll
                for (int m = 0; m < 4; ++m)
#pragma unroll
                    for (int n = 0; n < 2; ++n) acc[a][b][m][n] = (f32x4){0.f, 0.f, 0.f, 0.f};
        cur = nxt; cA = nA; cB = nB; ++ui;
        if constexpr (ALIGN_EPI) { if (wr == 1) PG8_BAR; }
    }
    PG8_WAIT_V(0);
    if constexpr (!ALIGN_EPI) { if (wr == 0) PG8_BAR; }
    PG8_BAR;
    if constexpr (Epi::AFTER_DRAIN) { E.fused(acc, cur, wr, wc, fr, fq, lds, wid, lane); S.done(cur); }
#undef PG8_SA
#undef PG8_SB
#undef PG8_STAGE
#undef PG8_LDA
#undef PG8_LDB
#undef PG8_LDBX
#undef PG8_MMA
#undef PG8_WAIT_V
#undef PG8_WAIT_L
#undef PG8_BAR
#undef PG8_SCHED
}
}

#ifndef PG8_SP2
#define PG8_SP2 true
#endif
#ifndef PG8_ALIGN
#define PG8_ALIGN true
#endif
#define GAS __attribute__((address_space(1)))
#define LAS __attribute__((address_space(3)))
typedef unsigned short bf16;
typedef unsigned v4u __attribute__((ext_vector_type(4)));
typedef float f32x4 __attribute__((ext_vector_type(4)));
typedef short bf16x8 __attribute__((ext_vector_type(8)));
typedef GAS unsigned gu32;
typedef GAS unsigned long long gu64;
#define RLX_AGENT __ATOMIC_RELAXED, __HIP_MEMORY_SCOPE_AGENT
#define LDS_WAIT() asm volatile("s_waitcnt lgkmcnt(0)" ::: "memory")
#define VM_WAIT() asm volatile("s_waitcnt vmcnt(0)" ::: "memory")
__device__ __forceinline__ unsigned long long rt() { return __builtin_amdgcn_s_memrealtime(); }
__device__ __forceinline__ unsigned f2bf(float f) { unsigned u = __builtin_bit_cast(unsigned, f); return (u + 0x7fffu + ((u >> 16) & 1u)) >> 16; }
typedef float f32x2_hw __attribute__((ext_vector_type(2))); typedef __bf16 bf16x2_hw __attribute__((ext_vector_type(2)));
__device__ __forceinline__ unsigned pk2(float lo, float hi) { const f32x2_hw v = {lo, hi}; return __builtin_bit_cast(unsigned, __builtin_convertvector(v, bf16x2_hw)); }

#define XB_TMO      128
#define XB_XCNT(j)  (256  + 64 * (j))
#define XB_XSUB(j)  (1280 + 64 * (j))
#define XB_XGEN(j)  (2304 + 64 * (j))
#define XB_TOP      3328
#define XB_TOPGEN   3392
#define XCD_BAR_WORDS 3456
#define XB_SPIN_CAP (1u << 18)

__device__ __forceinline__ unsigned xb_ld(unsigned* p)              { return __hip_atomic_load(p, __ATOMIC_RELAXED, __HIP_MEMORY_SCOPE_AGENT); }
__device__ __forceinline__ unsigned xb_add(unsigned* p, unsigned v) { return __hip_atomic_fetch_add(p, v, __ATOMIC_RELAXED, __HIP_MEMORY_SCOPE_AGENT); }
__device__ __forceinline__ unsigned xb_xcc_id() { return (unsigned)__builtin_amdgcn_s_getreg((3 << 11) | 20) & 0xFu; }
#define XB_SPIN(cond, bar) do { unsigned _sp = 0; while (cond) { __builtin_amdgcn_s_sleep(1); \
    if ((++_sp & 255u) == 0u) { if (xb_ld(&(bar)[XB_TMO])) break; if (_sp > XB_SPIN_CAP) { atomicAdd(&(bar)[XB_TMO], 1u); break; } } } } while (0)

struct XcdBarrier {
    unsigned* bar; unsigned x;
    volatile LAS unsigned* st;
};

__device__ __forceinline__ XcdBarrier xcd_barrier_post(unsigned* bar, volatile LAS unsigned* st, const bool leader) {
    XcdBarrier b; b.bar = bar; b.x = xb_xcc_id(); b.st = st;
    if (leader) (void)xb_add(&bar[XB_XCNT(b.x)], 1u);
    return b;
}
__device__ __forceinline__ void xcd_barrier_complete(unsigned* bar, unsigned x, unsigned& nloc, unsigned& nx) {
    const unsigned G = gridDim.x * gridDim.y * gridDim.z;
    unsigned sum, cnt, mine, sp = 0u;
    for (;;) {
        sum = 0u; cnt = 0u; mine = 0u;
#pragma unroll
        for (unsigned j = 0; j < 16; ++j) { const unsigned c = xb_ld(&bar[XB_XCNT(j)]); sum += c; cnt += (c > 0u) ? 1u : 0u; mine = (j == x) ? c : mine; }
        if (sum == G) break;
        __builtin_amdgcn_s_sleep(1);
        if ((++sp & 255u) == 0u) { if (xb_ld(&bar[XB_TMO])) break; if (sp > XB_SPIN_CAP) { atomicAdd(&bar[XB_TMO], 1u); break; } }
    }
    nloc = mine > 0u ? mine : 1u; nx = cnt > 0u ? cnt : 1u;
}

__device__ __forceinline__ void xcd_barrier(const XcdBarrier& b, const bool leader) {
    asm volatile("s_waitcnt vmcnt(0)" ::: "memory");
    __syncthreads();
    if (leader) {
        unsigned* bar = b.bar;
        __builtin_amdgcn_s_waitcnt(0);
        unsigned nloc = b.st[0], nx = b.st[1];
        if (nloc == 0u) { xcd_barrier_complete(bar, b.x, nloc, nx); b.st[0] = nloc; b.st[1] = nx; }
        const unsigned old = xb_add(&bar[XB_XSUB(b.x)], 1u);
        const unsigned gen = old / nloc;
        if (old + 1u == (gen + 1u) * nloc) {
            __builtin_amdgcn_fence(__ATOMIC_RELEASE, "agent");
            asm volatile("s_waitcnt vmcnt(0)" ::: "memory");
            const unsigned og = xb_add(&bar[XB_TOP], 1u);
            const unsigned tg = og / nx;
            if (og + 1u == (tg + 1u) * nx) xb_add(&bar[XB_TOPGEN], 1u);
            else XB_SPIN(xb_ld(&bar[XB_TOPGEN]) == tg, bar);
            __builtin_amdgcn_fence(__ATOMIC_ACQUIRE, "agent");
            xb_add(&bar[XB_XGEN(b.x)], 1u);
            asm volatile("s_waitcnt vmcnt(0)" ::: "memory");
        } else {
            XB_SPIN(xb_ld(&bar[XB_XGEN(b.x)]) == gen, bar);
            __builtin_amdgcn_fence(__ATOMIC_ACQUIRE, "agent");
            asm volatile("s_waitcnt vmcnt(0)" ::: "memory");
        }
    }
    __syncthreads();
}


constexpr int NWAVES = 8, NTHREADS = 512;
constexpr int RING_BYTES = 131072, LDSCTL_OFF = RING_BYTES, MISC_OFF = LDSCTL_OFF + 320, LDS_BYTES = 147456;
typedef unsigned v2u __attribute__((ext_vector_type(2)));
typedef float f32x16 __attribute__((ext_vector_type(16)));

#define DPP_MOV(v, ctrl) __int_as_float(__builtin_amdgcn_update_dpp(0, __float_as_int(v), (ctrl), 0xf, 0xf, false))
__device__ __forceinline__ float row16_sum(float v) { v += DPP_MOV(v, 0xB1); v += DPP_MOV(v, 0x4E); v += DPP_MOV(v, 0x141); v += DPP_MOV(v, 0x140); return v; }
__device__ __forceinline__ float row16_max(float v) { v = fmaxf(v, DPP_MOV(v, 0xB1)); v = fmaxf(v, DPP_MOV(v, 0x4E)); v = fmaxf(v, DPP_MOV(v, 0x141)); v = fmaxf(v, DPP_MOV(v, 0x140)); return v; }
__device__ __forceinline__ float wave_sum(float v) { v = row16_sum(v); v += __shfl_xor(v, 16); v += __shfl_xor(v, 32); return v; }
__device__ __forceinline__ float wave_max(float v) { v = row16_max(v); v = fmaxf(v, __shfl_xor(v, 16)); v = fmaxf(v, __shfl_xor(v, 32)); return v; }
__device__ __forceinline__ float sigm(float x) { return __builtin_amdgcn_rcpf(1.f + __builtin_amdgcn_exp2f(x * -LOG2E)); }
__device__ __forceinline__ float bf2f(unsigned short b) { return __uint_as_float((unsigned)b << 16); }
__device__ __forceinline__ void unpack8(const v4u w, float* o) {
    o[0] = __uint_as_float(w.x << 16); o[1] = __uint_as_float(w.x & 0xffff0000u); o[2] = __uint_as_float(w.y << 16); o[3] = __uint_as_float(w.y & 0xffff0000u);
    o[4] = __uint_as_float(w.z << 16); o[5] = __uint_as_float(w.z & 0xffff0000u); o[6] = __uint_as_float(w.w << 16); o[7] = __uint_as_float(w.w & 0xffff0000u);
}
__device__ __forceinline__ v4u pack8(const float* v) { v4u w; w.x = pk2(v[0], v[1]); w.y = pk2(v[2], v[3]); w.z = pk2(v[4], v[5]); w.w = pk2(v[6], v[7]); return w; }
__device__ __forceinline__ float rstd_from_parts(const float* ssq, int row) {
    const f32x4* p = (const f32x4*)(ssq + (size_t)row * 16); const f32x4 a = (p[0] + p[1]) + (p[2] + p[3]);
    return rsqrtf(((a.x + a.y) + (a.z + a.w)) * (1.f / D) + EPS);
}
__device__ __forceinline__ float rstd_quad(const float* __restrict__ ssq, int row, int fq) {
    const f32x4 a = *((const f32x4*)(ssq + (size_t)row * 16) + fq); float s = (a.x + a.y) + (a.z + a.w);
    s += __shfl_xor(s, 16); s += __shfl_xor(s, 32);
    return rsqrtf(s * (1.f / D) + EPS);
}

struct Frame { LAS unsigned char* lds; int tid, lane, wave, G, bid; unsigned char* ws;
    __device__ __forceinline__ void refresh() { int l; asm volatile("v_mbcnt_lo_u32_b32 %0, -1, 0\n\tv_mbcnt_hi_u32_b32 %0, -1, %0" : "=v"(l)); lane = l; tid = wave * 64 + l; } };

__device__ __forceinline__ void conv_item(const float* __restrict__ W, int ldw, int K, bf16_t* __restrict__ WT, int n_st0, int src0, int k0, const float* __restrict__ gain, LAS float* scr, int lane) {
    f32x4 wv[8];
#pragma unroll
    for (int i = 0; i < 8; ++i) wv[i] = __builtin_nontemporal_load((const f32x4*)(W + (size_t)(k0 + 8 * i + (lane >> 3)) * ldw + src0 + 4 * (lane & 7)));
    if (gain) {
#pragma unroll
        for (int i = 0; i < 8; ++i) wv[i] = wv[i] * gain[k0 + 8 * i + (lane >> 3)]; }
#pragma unroll
    for (int i = 0; i < 8; ++i) { LAS float* d = scr + (8 * i + (lane >> 3)) * 33 + 4 * (lane & 7); d[0] = wv[i].x; d[1] = wv[i].y; d[2] = wv[i].z; d[3] = wv[i].w; }
    LDS_WAIT(); asm volatile("" ::: "memory");
    const int c = lane & 7;
#pragma unroll
    for (int j = 0; j < 4; ++j) { const int n = (lane >> 3) + 8 * j; const LAS float* s = scr + (8 * c) * 33 + n;
        v4u o; o.x = pk2(s[0 * 33], s[1 * 33]); o.y = pk2(s[2 * 33], s[3 * 33]); o.z = pk2(s[4 * 33], s[5 * 33]); o.w = pk2(s[6 * 33], s[7 * 33]);
        *(GAS v4u*)(WT + (size_t)(n_st0 + n) * K + k0 + 8 * c) = o; }
    LDS_WAIT(); asm volatile("" ::: "memory");
}
template <int MAP> __device__ __forceinline__ void conv_matrix(Frame& F, const float* W, int ldw, int K, int Nst, bf16_t* WT, const float* gain, int gw, int ngw) {
    LAS float* scr = (LAS float*)(F.lds + F.wave * 16384);
    const int nblk = Nst / 32, nitems = (K / 64) * nblk;
    for (int it = gw; it < nitems; it += ngw) {
        const int kb = it / nblk, nb = it % nblk, n_st0 = 32 * nb; int src0 = n_st0;
        if (MAP == 1) { const int pn = n_st0 >> 8, c = n_st0 & 255, bj = c >> 7, wcg = (c & 127) >> 5; const int n = 256 * pn + 64 * wcg + 32 * bj; src0 = n + ((n >= 3 * D) ? H : 0); }
        conv_item(W, ldw, K, WT, n_st0, src0, 64 * kb, gain, scr, F.lane);
    }
}
__device__ __forceinline__ float row_to_bf16(const float* xrow, bf16_t* orow, float* ssqrow, int lane) {
    const GAS f32x4* xr = (const GAS f32x4*)xrow + lane;
    f32x4 v[4]; float s = 0.f;
#pragma unroll
    for (int j = 0; j < 4; ++j) { v[j] = xr[64 * j]; s += (v[j].x * v[j].x + v[j].y * v[j].y) + (v[j].z * v[j].z + v[j].w * v[j].w); }
    s = wave_sum(s);
    GAS unsigned long long* o8 = (GAS unsigned long long*)orow + lane;
#pragma unroll
    for (int j = 0; j < 4; ++j) o8[64 * j] = (unsigned long long)pk2(v[j].x, v[j].y) | ((unsigned long long)pk2(v[j].z, v[j].w) << 32);
    if (ssqrow && lane < 4) ((f32x4*)ssqrow)[lane] = (lane == 0) ? (f32x4){s, 0.f, 0.f, 0.f} : (f32x4){0.f, 0.f, 0.f, 0.f};
    return s;
}

template <bool ABF16> __device__ __forceinline__ void side_gemm(const void* A1, const float* A2, const bf16_t* Wt, int N, int K, float* out, int gw, int ngw, int lane) {
    const int fr = lane & 15, fq = lane >> 4;
    for (int tile = gw; tile < N / 16; tile += ngw) {
        f32x4 acc = (f32x4){0.f, 0.f, 0.f, 0.f};
        const bf16_t* wrow = Wt + (size_t)(tile * 16 + fr) * K + 8 * fq;
#pragma unroll 8
        for (int k0 = 0; k0 < K; k0 += 32) {
            const bf16x8 b = *(const bf16x8*)(wrow + k0);
            bf16x8 a;
            if (ABF16) a = *(const bf16x8*)((const bf16_t*)A1 + (size_t)fr * K + k0 + 8 * fq);
            else {
                const float* p = (const float*)A1 + (size_t)fr * K + k0 + 8 * fq;
                f32x4 x0 = *(const f32x4*)p, x1 = *(const f32x4*)(p + 4);
                if (A2) { const float* q = A2 + (size_t)fr * K + k0 + 8 * fq; x0 += *(const f32x4*)q; x1 += *(const f32x4*)(q + 4); }
                const v4u w = (v4u){pk2(x0.x, x0.y), pk2(x0.z, x0.w), pk2(x1.x, x1.y), pk2(x1.z, x1.w)};
                a = __builtin_bit_cast(bf16x8, w);
            }
            acc = __builtin_amdgcn_mfma_f32_16x16x32_bf16(a, b, acc, 0, 0, 0);
        }
#pragma unroll
        for (int e = 0; e < 4; ++e) out[(size_t)(4 * fq + e) * N + tile * 16 + fr] = acc[e];
    }
}
__device__ __forceinline__ void meta_consolidate(const float* X1, const float* X2, float* dst, float* mssq, int wave, int lane) {
#pragma unroll
    for (int rr = 0; rr < 2; ++rr) {
        const int m = wave * 2 + rr; float s = 0.f;
#pragma unroll
        for (int j = 0; j < 4; ++j) { const int c = 4 * lane + 256 * j; f32x4 v = *(const f32x4*)(X1 + (size_t)m * D + c); if (X2) v += *(const f32x4*)(X2 + (size_t)m * D + c);
            if (dst) *(f32x4*)(dst + (size_t)m * D + c) = v; s += (v.x * v.x + v.y * v.y) + (v.z * v.z + v.w * v.w); }
        s = wave_sum(s);
        if (lane == 0) mssq[m] = s;
    }
}


struct ReverseOrder {
    pg8::StaticOrder B; int R;
    __host__ __device__ void init(int M_, int N_, int G_, int c_) { B.init(M_, N_, G_, c_); R = 0; pg8::Unit t; while (B.next(R, t)) ++R; }
    __host__ __device__ bool next(int i, pg8::Unit& u) const { if (i >= R) return false; return B.next(R - 1 - i, u); }
    __device__ __forceinline__ void a_ready(const pg8::Unit&) const {}
    __device__ __forceinline__ void done(const pg8::Unit&) const {}
};
using pg8::Unit;
struct EpiGate {
    static constexpr int EID = 0;
    static constexpr bool PERM = true, AFTER_DRAIN = false;
    bf16_t* __restrict__ A; const float* __restrict__ ssq;
    __device__ __forceinline__ void operator()(const f32x4 (&acc)[2][2][4][2], const Unit& u, int wr, int wc, int fr, int fq) const {
        const int row0 = u.pm * 256 + wr * 64 + fr, col0 = u.pn * 256 + wc * 32 + 8 * fq;
        float rsv[2][4];
#pragma unroll
        for (int ai = 0; ai < 2; ++ai)
#pragma unroll
            for (int m = 0; m < 4; ++m) rsv[ai][m] = rstd_quad(ssq, row0 + ai * 128 + m * 16, fq);
#pragma unroll
        for (int ai = 0; ai < 2; ++ai)
#pragma unroll
            for (int m = 0; m < 4; ++m) {
                const int row = row0 + ai * 128 + m * 16; const float rs = rsv[ai][m];
                bf16_t* rowp = A + (size_t)row * FF + col0;
#pragma unroll
                for (int bj = 0; bj < 2; ++bj) { const f32x4 v0 = acc[ai][bj][m][0] * rs, v1 = acc[ai][bj][m][1] * rs;
                    v4u w; w.x = pk2(v0[0], v0[1]); w.y = pk2(v0[2], v0[3]); w.z = pk2(v1[0], v1[1]); w.w = pk2(v1[2], v1[3]);
                    *(v4u*)(rowp + bj * 128) = w; }
            }
    }
    __device__ __forceinline__ void part(const f32x4 (&acc)[2][2][4][2], const Unit& u, int wr, int wc, int fr, int fq) const {
        const int row0 = u.r0 + wr * 64 + fr, col0 = u.c0 + wc * 32 + 8 * fq;
        float rsv[4];
#pragma unroll
        for (int m = 0; m < 4; ++m) rsv[m] = rstd_quad(ssq, row0 + m * 16, fq);
#pragma unroll
        for (int m = 0; m < 4; ++m) {
            const float rs = rsv[m]; bf16_t* rowp = A + (size_t)(row0 + m * 16) * FF + col0;
#pragma unroll
            for (int h = 0; h < 3; ++h) { const f32x4 v0 = acc[h >> 1][h & 1][m][0] * rs, v1 = acc[h >> 1][h & 1][m][1] * rs;
                v4u w; w.x = pk2(v0[0], v0[1]); w.y = pk2(v0[2], v0[3]); w.z = pk2(v1[0], v1[1]); w.w = pk2(v1[2], v1[3]);
                *(v4u*)(rowp + h * 128) = w; }
        }
    }
};
struct EpiUp {
    static constexpr int EID = 1;
    static constexpr bool PERM = true, AFTER_DRAIN = false;
    const bf16_t* __restrict__ A; bf16_t* __restrict__ Y; const float* __restrict__ ssq; const float* __restrict__ cw; const float* __restrict__ cb; const float* __restrict__ mwg; const float* __restrict__ mssq;
    static __device__ __forceinline__ unsigned shr1(unsigned prevgrp, unsigned cur) { const int t = __builtin_amdgcn_update_dpp(0, (int)prevgrp, 0x121, 0xf, 0xf, false); return (unsigned)__builtin_amdgcn_update_dpp(t, (int)cur, 0x111, 0xf, 0xf, false); }
    static __device__ __forceinline__ unsigned shr2(unsigned prevgrp, unsigned cur) { const int t = __builtin_amdgcn_update_dpp(0, (int)prevgrp, 0x122, 0xf, 0xf, false); return (unsigned)__builtin_amdgcn_update_dpp(t, (int)cur, 0x112, 0xf, 0xf, false); }
    __device__ __forceinline__ void slab(const f32x4 (&aq)[4][2], const int rtop, const int c, const float (&rsv)[4], const int fr) const {
        const int rh = rtop - 16, ih = (rtop & (SEQ - 1)) - 16;
        v4u cur[4], hal;
#pragma unroll
        for (int m = 0; m < 4; ++m) cur[m] = *(const v4u*)(A + (size_t)(rtop + m * 16) * FF + c);
        if (ih >= 0) hal = *(const v4u*)(A + (size_t)(fr >= 14 ? rh : rtop) * FF + c);
        else {
            hal = (v4u){0u, 0u, 0u, 0u};
            if (fr >= 14) { const int mm = NMETA + ih; const float mr = rsqrtf(mssq[mm] * (1.f / D) + EPS); float t[8];
#pragma unroll
                for (int e = 0; e < 8; ++e) t[e] = mr * mwg[(size_t)mm * FF + c + e];
                hal = pack8(t); }
        }
        f32x4 w0[2], w1[2], w2[2], bb[2];
#pragma unroll
        for (int q = 0; q < 2; ++q) { w0[q] = *(const f32x4*)(cw + c + 4 * q); w1[q] = *(const f32x4*)(cw + FF + c + 4 * q); w2[q] = *(const f32x4*)(cw + 2 * FF + c + 4 * q); bb[q] = *(const f32x4*)(cb + c + 4 * q); }
#pragma unroll
        for (int m = 0; m < 4; ++m) {
            const int row = rtop + m * 16; const float rs = rsv[m];
            v4u yo;
#pragma unroll
            for (int q = 0; q < 2; ++q) {
                unsigned p1[2], p2[2];
#pragma unroll
                for (int e = 0; e < 2; ++e) { const int dw = 2 * q + e; const unsigned pg = m == 0 ? hal[dw] : cur[m - 1][dw]; p1[e] = shr1(pg, cur[m][dw]); p2[e] = shr2(pg, cur[m][dw]); }
                float y[4];
#pragma unroll
                for (int e = 0; e < 4; ++e) {
                    const int dw = e >> 1; const bool hi16 = e & 1; const unsigned cu = cur[m][2 * q + dw];
                    const float ac = hi16 ? __uint_as_float(cu & 0xffff0000u) : __uint_as_float(cu << 16);
                    const float a1 = hi16 ? __uint_as_float(p1[dw] & 0xffff0000u) : __uint_as_float(p1[dw] << 16);
                    const float a2 = hi16 ? __uint_as_float(p2[dw] & 0xffff0000u) : __uint_as_float(p2[dw] << 16);
                    const float z = bb[q][e] + w0[q][e] * a2 + w1[q][e] * a1 + w2[q][e] * ac; const float uu = aq[m][q][e] * rs; y[e] = z * sigm(z) * uu;
                }
                yo[2 * q] = pk2(y[0], y[1]); yo[2 * q + 1] = pk2(y[2], y[3]);
            }
            *(v4u*)(Y + (size_t)row * FF + c) = yo;
        }
    }
    __device__ __forceinline__ void operator()(const f32x4 (&acc)[2][2][4][2], const Unit& u, int wr, int wc, int fr, int fq) const {
        const int row0 = u.pm * 256 + wr * 64 + fr, col0 = u.pn * 256 + wc * 32 + 8 * fq;
#pragma unroll
        for (int ai = 0; ai < 2; ++ai) {
            const int rtop = row0 + ai * 128;
            float rsv[4];
#pragma unroll
            for (int m = 0; m < 4; ++m) rsv[m] = rstd_quad(ssq, rtop + m * 16, fq);
#pragma unroll
            for (int bj = 0; bj < 2; ++bj) slab(acc[ai][bj], rtop, col0 + bj * 128, rsv, fr);
        }
    }
    __device__ __forceinline__ void part(const f32x4 (&acc)[2][2][4][2], const Unit& u, int wr, int wc, int fr, int fq) const {
        const int rtop = u.r0 + wr * 64 + fr, col0 = u.c0 + wc * 32 + 8 * fq;
        float rsv[4];
#pragma unroll
        for (int m = 0; m < 4; ++m) rsv[m] = rstd_quad(ssq, rtop + m * 16, fq);
#pragma unroll
        for (int h = 0; h < 3; ++h) slab(acc[h >> 1][h & 1], rtop, col0 + h * 128, rsv, fr);
    }
};
struct EpiRes {
    static constexpr int EID = 2;
    static constexpr bool PERM = true, AFTER_DRAIN = false;
    const float* basef; float* outf; bf16_t* hb; float* __restrict__ ssq;
    __device__ __forceinline__ void operator()(const f32x4 (&acc)[2][2][4][2], const Unit& u, int wr, int wc, int fr, int fq) const {
        const int row0 = u.pm * 256 + wr * 64 + fr, col0 = u.pn * 256 + wc * 32 + 8 * fq;
#pragma unroll
        for (int ai = 0; ai < 2; ++ai) {
            f32x4 bs[4][2][2];
#pragma unroll
            for (int m = 0; m < 4; ++m)
#pragma unroll
                for (int bj = 0; bj < 2; ++bj) { const size_t o = (size_t)(row0 + ai * 128 + m * 16) * D + col0 + bj * 128;
                    if (basef) { bs[m][bj][0] = *(const f32x4*)(basef + o); bs[m][bj][1] = *(const f32x4*)(basef + o + 4); }
                    else { const v4u w = *(const v4u*)(hb + o);
                        bs[m][bj][0] = (f32x4){__uint_as_float(w.x << 16), __uint_as_float(w.x & 0xffff0000u), __uint_as_float(w.y << 16), __uint_as_float(w.y & 0xffff0000u)};
                        bs[m][bj][1] = (f32x4){__uint_as_float(w.z << 16), __uint_as_float(w.z & 0xffff0000u), __uint_as_float(w.w << 16), __uint_as_float(w.w & 0xffff0000u)}; } }
            asm volatile("" ::: "memory");
#pragma unroll
            for (int m = 0; m < 4; ++m) {
                const int row = row0 + ai * 128 + m * 16; const size_t off = (size_t)row * D + col0; float s = 0.f;
#pragma unroll
                for (int bj = 0; bj < 2; ++bj) { const size_t o = off + bj * 128; const f32x4 v0 = acc[ai][bj][m][0] + bs[m][bj][0], v1 = acc[ai][bj][m][1] + bs[m][bj][1];
                    s += ((v0.x * v0.x + v0.y * v0.y) + (v0.z * v0.z + v0.w * v0.w)) + ((v1.x * v1.x + v1.y * v1.y) + (v1.z * v1.z + v1.w * v1.w));
                    if (outf) { __builtin_nontemporal_store(v0, (f32x4*)(outf + o)); __builtin_nontemporal_store(v1, (f32x4*)(outf + o + 4)); }
                    else { v4u w; w.x = pk2(v0.x, v0.y); w.y = pk2(v0.z, v0.w); w.z = pk2(v1.x, v1.y); w.w = pk2(v1.z, v1.w); *(v4u*)(hb + o) = w; } }
                if (ssq) { s += __shfl_xor(s, 16); s += __shfl_xor(s, 32); if (fq == 0) ssq[(size_t)row * 16 + u.pn * 4 + wc] = s; }
            }
            asm volatile("" ::: "memory");
        }
    }
};
struct EpiFoxIn {
    static constexpr int EID = 3;
    static constexpr bool PERM = true, AFTER_DRAIN = false;
    bf16_t *Q, *K, *V, *GT; const float* __restrict__ ssq; const float* __restrict__ gq; const float* __restrict__ gk;
    __device__ __forceinline__ void operator()(const f32x4 (&acc)[2][2][4][2], const Unit& u, int wr, int wc, int fr, int fq) const {
        const int sec = u.pn >> 2, h = 4 * (u.pn & 3) + wc, row0 = u.pm * 256 + wr * 64 + fr;
        float rsv[2][4];
#pragma unroll
        for (int ai = 0; ai < 2; ++ai)
#pragma unroll
            for (int m = 0; m < 4; ++m) rsv[ai][m] = rstd_quad(ssq, row0 + ai * 128 + m * 16, fq);
        float gg[2][8];
        if (sec < 2) { const float* g = sec == 0 ? gq : gk;
#pragma unroll
            for (int bj = 0; bj < 2; ++bj)
#pragma unroll
                for (int e = 0; e < 8; ++e) gg[bj][e] = g[32 * bj + 8 * fq + e]; }
#pragma unroll
        for (int ai = 0; ai < 2; ++ai)
#pragma unroll
            for (int m = 0; m < 4; ++m) {
                const int row = row0 + ai * 128 + m * 16; const float rs = rsv[ai][m];
                const int b = row >> 13, i = row & (SEQ - 1); const size_t kvrow = (size_t)b * KVROWS + KV_MAIN0 + i;
                float x[2][8];
#pragma unroll
                for (int bj = 0; bj < 2; ++bj)
#pragma unroll
                    for (int e = 0; e < 8; ++e) x[bj][e] = acc[ai][bj][m][e >> 2][e & 3] * rs;
                if (sec < 2) {
                    float ss = 0.f;
#pragma unroll
                    for (int bj = 0; bj < 2; ++bj)
#pragma unroll
                        for (int e = 0; e < 8; ++e) ss += x[bj][e] * x[bj][e];
                    ss += __shfl_xor(ss, 16); ss += __shfl_xor(ss, 32);
                    const float hr = rsqrtf(ss * (1.f / HD) + EPS) * (sec == 0 ? C2 : 1.f);
#pragma unroll
                    for (int bj = 0; bj < 2; ++bj)
#pragma unroll
                        for (int e = 0; e < 8; ++e) x[bj][e] *= hr * gg[bj][e];
                } else if (sec == 3) {
#pragma unroll
                    for (int bj = 0; bj < 2; ++bj)
#pragma unroll
                        for (int e = 0; e < 8; ++e) x[bj][e] = sigm(x[bj][e]);
                }
                bf16_t* dst = sec == 0 ? Q + (size_t)row * D : sec == 1 ? K + kvrow * D : sec == 2 ? V + kvrow * D : GT + (size_t)row * D;
                dst += h * HD + 8 * fq;
#pragma unroll
                for (int bj = 0; bj < 2; ++bj) *(v4u*)(dst + 32 * bj) = pack8(x[bj]);
            }
    }
};
__device__ __forceinline__ void row_load4(const float* xrow, f32x4 (&v)[4], int lane) {
    const GAS f32x4* xr = (const GAS f32x4*)xrow + 2 * lane;
#pragma unroll
    for (int j = 0; j < 4; ++j) v[j] = xr[128 * (j >> 1) + (j & 1)];
}
__device__ __forceinline__ void row_load4n(const float* xrow, f32x4 (&v)[4], int lane) {
    const GAS f32x4* xr = (const GAS f32x4*)xrow + lane;
#pragma unroll
    for (int j = 0; j < 4; ++j) v[j] = __builtin_nontemporal_load(xr + 64 * j);
}
__device__ __forceinline__ void row_pass_fl(const f32x4 (&v)[4], bf16_t* orow, float* ssqrow, float* f32copy, float* mssq1, const LAS f32x4* wfl, const float* bfv, float* lf0, float* lf1, int lane) {
    typedef float f32x2v __attribute__((ext_vector_type(2)));
    float s = 0.f;
#pragma unroll
    for (int j = 0; j < 4; ++j) s += (v[j].x * v[j].x + v[j].y * v[j].y) + (v[j].z * v[j].z + v[j].w * v[j].w);
    s = wave_sum(s);
    if (orow) {
#pragma unroll
        for (int jj = 0; jj < 2; ++jj) { const f32x4 a = v[2 * jj], b = v[2 * jj + 1];
            ((GAS v4u*)orow)[64 * jj + lane] = (v4u){pk2(a.x, a.y), pk2(a.z, a.w), pk2(b.x, b.y), pk2(b.z, b.w)}; } }
    if (ssqrow && lane < 4) ((f32x4*)ssqrow)[lane] = (lane == 0) ? (f32x4){s, 0.f, 0.f, 0.f} : (f32x4){0.f, 0.f, 0.f, 0.f};
    if (f32copy) {
#pragma unroll
        for (int j = 0; j < 4; ++j) ((f32x4*)f32copy)[128 * (j >> 1) + 2 * lane + (j & 1)] = v[j]; }
    if (mssq1 && lane == 0) *mssq1 = s;
    const float rstd = rsqrtf(s * (1.f / D) + EPS);
    float mine = 0.f;
#pragma unroll
    for (int h = 0; h < H; ++h) {
        f32x2v a2 = (f32x2v){0.f, 0.f};
#pragma unroll
        for (int j = 0; j < 4; ++j) { const f32x4 w = wfl[h * 256 + 64 * j + lane];
            a2 = (f32x2v){v[j].x, v[j].y} * (f32x2v){w.x, w.y} + a2; a2 = (f32x2v){v[j].z, v[j].w} * (f32x2v){w.z, w.w} + a2; }
        const float a = row16_sum(a2.x + a2.y);
        mine = ((lane & 15) == h) ? a : mine;
    }
    mine += __shfl_xor(mine, 16); mine += __shfl_xor(mine, 32);
    if (lane < H) { const float xx = mine * rstd + bfv[lane]; const float lf = fminf(xx, 0.f) - log1pf(__expf(-fabsf(xx))); *lf0 = lf; if (lf1) *lf1 = lf; }
}
struct EpiHgIn {
    static constexpr int EID = 4;
    static constexpr bool PERM = true, AFTER_DRAIN = false;
    bf16_t *QH, *VH, *G; _Float16* LF; const float* __restrict__ ssq; const float* __restrict__ lbt;
    __device__ __forceinline__ void operator()(const f32x4 (&acc)[2][2][4][2], const Unit& u, int wr, int wc, int fr, int fq) const {
        const int sec = u.pn >> 2, row0 = u.pm * 256 + wr * 64 + fr, col0 = (u.pn & 3) * 256 + wc * 32 + 8 * fq;
        float rsv[2][4];
#pragma unroll
        for (int ai = 0; ai < 2; ++ai)
#pragma unroll
            for (int m = 0; m < 4; ++m) rsv[ai][m] = rstd_quad(ssq, row0 + ai * 128 + m * 16, fq);
        if (sec == 1) {
#pragma unroll
            for (int bj = 0; bj < 2; ++bj) {
                const f32x4 l0 = *(const f32x4*)(lbt + col0 + bj * 128), l1 = *(const f32x4*)(lbt + col0 + bj * 128 + 4);
#pragma unroll
                for (int ai = 0; ai < 2; ++ai)
#pragma unroll
                    for (int m = 0; m < 4; ++m) {
                        const int row = row0 + ai * 128 + m * 16; const float rs = rsv[ai][m];
                        _Float16* o = LF + (size_t)row * D + col0 + bj * 128;
                        typedef _Float16 h8_t __attribute__((ext_vector_type(8)));
                        h8_t y;
#pragma unroll
                        for (int e = 0; e < 4; ++e) { y[e] = (_Float16)__logf(l0[e] + (1.f - l0[e]) * sigm(acc[ai][bj][m][0][e] * rs)); y[4 + e] = (_Float16)__logf(l1[e] + (1.f - l1[e]) * sigm(acc[ai][bj][m][1][e] * rs)); }
                        *(h8_t*)o = y;
                        asm volatile("" ::: "memory");
                    }
            }
        } else {
            bf16_t* dst = QH + (size_t)(sec == 0 ? 0 : sec - 1) * ((size_t)M * D);
#pragma unroll
            for (int ai = 0; ai < 2; ++ai)
#pragma unroll
                for (int m = 0; m < 4; ++m) {
                    const int row = row0 + ai * 128 + m * 16; const float rs = rsv[ai][m];
#pragma unroll
                    for (int bj = 0; bj < 2; ++bj) {
                        float x[8];
#pragma unroll
                        for (int e = 0; e < 8; ++e) { const float v = acc[ai][bj][m][e >> 2][e & 3] * rs; x[e] = sec == 0 ? v * sigm(v) : sec == 3 ? sigm(v) : v; }
                        *(v4u*)(dst + (size_t)row * D + col0 + bj * 128) = pack8(x);
                    }
                    asm volatile("" ::: "memory");
                }
        }
    }
};
#include <hip/hip_bf16.h>
#include <cmath>
namespace attn_body {
using bf16=__hip_bfloat16;
using bf16x8=__attribute__((ext_vector_type(8)))short;
using s16x4=__attribute__((ext_vector_type(4)))short;
using f32x16=__attribute__((ext_vector_type(16)))float;
using u32x4=__attribute__((ext_vector_type(4)))unsigned;
constexpr int BATCH=2,NHEAD=16,SEQ=8192,KVR=8320,D=64,DM=NHEAD*D;
constexpr int NW=8,QBLK=32,QB=QBLK*NW,KVBLK=64,NQB=SEQ/QB;
constexpr int ATTN_PITCH=DM, ATTN_UNIT_ROWS=QB;
__device__ __forceinline__ int crow(int r,int hi){return (r&3)+8*(r>>2)+4*hi;}
#define SBAR() __builtin_amdgcn_sched_barrier(0)
__device__ __forceinline__ void cmask(f32x16&p0,f32x16&p1,int jb,int qrel,int hi){
  const float NEG=-INFINITY; int kb=64*jb+4*hi;
  #pragma unroll
  for(int r=0;r<16;++r){int kv=kb+(r&3)+8*(r>>2); if(kv>qrel)p0[r]=NEG; if(kv+32>qrel)p1[r]=NEG;}
}

constexpr int NSLOT=3, SLOTB=8192;
constexpr int LDS_K=0, LDS_V=NSLOT*SLOTB, LDS_WS=2*NSLOT*SLOTB, LDS_OST=LDS_WS+NW*64*4, LDS_BYTES=LDS_OST+NW*4096;
constexpr float C2=0.125f*1.4426950408889634f;
__device__ __forceinline__ void glds16(const void*gsrc,unsigned lds_dst){unsigned keep;
  asm volatile("s_mov_b32 %0, m0\n\ts_mov_b32 m0, %2\n\ts_nop 0\n\tglobal_load_lds_dwordx4 %1, off\n\ts_mov_b32 m0, %0":"=&s"(keep):"v"(gsrc),"s"(lds_dst):"memory");}
__device__ __forceinline__ float max3f(float a,float b,float c){float r;asm("v_max3_f32 %0, %1, %2, %3":"=v"(r):"v"(a),"v"(b),"v"(c));return r;}
__device__ __forceinline__ float max2f(float a,float b){float r;asm("v_max_f32_e32 %0, %1, %2":"=v"(r):"v"(a),"v"(b));return r;}
__device__ __forceinline__ float fadd_s(float a,float b){float r;asm("v_add_f32_e32 %0, %1, %2":"=v"(r):"v"(a),"v"(b));return r;}
__device__ __forceinline__ float fsub_s(float a,float b){float r;asm("v_sub_f32_e32 %0, %1, %2":"=v"(r):"v"(a),"v"(b));return r;}
typedef float f32x2_t __attribute__((ext_vector_type(2))); typedef __bf16 bf16x2_t __attribute__((ext_vector_type(2)));
__device__ __forceinline__ unsigned cvtpk_s(float lo,float hi){f32x2_t v={lo,hi};bf16x2_t b=__builtin_convertvector(v,bf16x2_t);return __builtin_bit_cast(unsigned,b);}
#define WAIT_BAR(N) asm volatile("s_waitcnt vmcnt(" #N ") lgkmcnt(0)\n\ts_barrier":::"memory")

__device__ __forceinline__ void qkt(f32x16&p0,f32x16&p1,const char*Kslot,const bf16x8*qr,bf16x8 ka0,bf16x8 ka1,bf16x8 qa,int r32,int hi){
  const char*kb=Kslot+hi*1024+r32*16;
  p0=__builtin_amdgcn_mfma_f32_32x32x16_bf16(ka0,qa,f32x16{},0,0,0);p1=__builtin_amdgcn_mfma_f32_32x32x16_bf16(ka1,qa,f32x16{},0,0,0);
  #pragma unroll
  for(int d0=0;d0<4;++d0){
    const bf16x8 b0=*reinterpret_cast<const bf16x8*>(kb+d0*2048);
    const bf16x8 b1=*reinterpret_cast<const bf16x8*>(kb+d0*2048+512);
    p0=__builtin_amdgcn_mfma_f32_32x32x16_bf16(b0,qr[d0],p0,0,0,0);p1=__builtin_amdgcn_mfma_f32_32x32x16_bf16(b1,qr[d0],p1,0,0,0);}
}
typedef __attribute__((address_space(3))) const char* lds_cptr;
typedef short v4i16_t __attribute__((ext_vector_type(4)));
__device__ __forceinline__ void kload8(bf16x8*kf,lds_cptr kp){
  kf[0]=*(const __attribute__((address_space(3))) bf16x8*)(kp);      kf[1]=*(const __attribute__((address_space(3))) bf16x8*)(kp+512);
  kf[2]=*(const __attribute__((address_space(3))) bf16x8*)(kp+2048); kf[3]=*(const __attribute__((address_space(3))) bf16x8*)(kp+2560);
  kf[4]=*(const __attribute__((address_space(3))) bf16x8*)(kp+4096); kf[5]=*(const __attribute__((address_space(3))) bf16x8*)(kp+4608);
  kf[6]=*(const __attribute__((address_space(3))) bf16x8*)(kp+6144); kf[7]=*(const __attribute__((address_space(3))) bf16x8*)(kp+6656);
}
__device__ __forceinline__ void kload2(bf16x8*kf,lds_cptr kp,int j){ kf[2*j]=*(const __attribute__((address_space(3))) bf16x8*)(kp+j*2048); kf[2*j+1]=*(const __attribute__((address_space(3))) bf16x8*)(kp+j*2048+512); }
__device__ __forceinline__ s16x4 vtr(lds_cptr p){ return __builtin_bit_cast(s16x4,__builtin_amdgcn_ds_read_tr16_b64_v4i16((__attribute__((address_space(3))) v4i16_t*)p)); }
__device__ __forceinline__ float rowmax(const f32x16&p0,const f32x16&p1){
  float a=max3f(p0[0],p0[1],p1[0]),b=max3f(p0[2],p0[3],p1[1]);a=max3f(a,p1[2],p1[3]);
  #pragma unroll
  for(int r=4;r<16;r+=4){a=max3f(a,p0[r],p0[r+1]);b=max3f(b,p0[r+2],p0[r+3]);a=max3f(a,p1[r],p1[r+1]);b=max3f(b,p1[r+2],p1[r+3]);}
  const float m=max2f(a,b);
  auto rr=__builtin_amdgcn_permlane32_swap(__float_as_uint(m),__float_as_uint(m),false,false);
  return max2f(__uint_as_float(rr[0]),__uint_as_float(rr[1]));
}
__device__ __forceinline__ void pv(f32x16*o,int vb,bf16x8 pa0,bf16x8 pa1,bf16x8 pa2,bf16x8 pa3){
  #pragma unroll
  for(int d0=0;d0<2;++d0){s16x4 lo[4],hi[4];
    #pragma unroll
    for(int ks=0;ks<4;++ks){
      asm volatile("ds_read_b64_tr_b16 %0,%1 offset:%c2":"=&v"(lo[ks]):"v"(vb),"i"(d0*4096+ks*1024):"memory");
      asm volatile("ds_read_b64_tr_b16 %0,%1 offset:%c2":"=&v"(hi[ks]):"v"(vb),"i"(d0*4096+ks*1024+512):"memory");}
    asm volatile("s_waitcnt lgkmcnt(0)":::"memory");SBAR();
    #define PK(k) (bf16x8){lo[k][0],lo[k][1],lo[k][2],lo[k][3],hi[k][0],hi[k][1],hi[k][2],hi[k][3]}
    o[d0]=__builtin_amdgcn_mfma_f32_32x32x16_bf16(pa0,PK(0),o[d0],0,0,0);
    o[d0]=__builtin_amdgcn_mfma_f32_32x32x16_bf16(pa1,PK(1),o[d0],0,0,0);
    o[d0]=__builtin_amdgcn_mfma_f32_32x32x16_bf16(pa2,PK(2),o[d0],0,0,0);
    o[d0]=__builtin_amdgcn_mfma_f32_32x32x16_bf16(pa3,PK(3),o[d0],0,0,0);
    #undef PK
  }
}

#ifndef ATTN_STORE16
#define ATTN_STORE16(p,v) (*(u32x4*)(p)=(v))
#endif
__device__ __forceinline__ void split3(float v,unsigned&p1,unsigned&p2,unsigned&p3){
  p1=cvtpk_s(v,0.f); const float r1=v-__uint_as_float(p1<<16); p2=cvtpk_s(r1,0.f); const float r2=r1-__uint_as_float(p2<<16); p3=cvtpk_s(r2,0.f); }
template<int THRL> __device__ __forceinline__ void attn_unit(int b,int h,int qb,const bf16*Q,const bf16*__restrict__ K,const bf16*__restrict__ V,bf16*O,const float*__restrict__ BIAS,const bf16*__restrict__ GATE,const int t0,char*shm,const int tid_in){
  const int tid=tid_in,lane=tid&63,r32=lane&31,hi=lane>>5; const int wid=__builtin_amdgcn_readfirstlane(tid>>6);
  const long rowbase=(long)b*SEQ; const int q0=qb*QB;
  const bf16*Qw=Q+(rowbase+q0+wid*QBLK)*DM+h*D;
  const float*Bh0=BIAS+(long)(b*NHEAD+h)*KVR;
  int lane_s=lane; asm volatile("":"+v"(lane_s));
  const long kvbase=(long)b*KVR+(long)t0*KVBLK;
  const bf16*Kh=K+kvbase*DM+h*D,*Vh=V+kvbase*DM+h*D; const float*Bh=Bh0+(long)t0*KVBLK;
  const float cq=-Bh0[128+q0+wid*QBLK+(lane_s&31)];
  const unsigned lds0=(unsigned)(uintptr_t)shm;
  float*wsf=(float*)(shm+LDS_WS)+wid*64;
  const bf16*ksrc=Kh+(long)lane*DM+wid*8;
  const bf16*vsrc=Vh+(long)(16*(wid&3)+(lane>>2))*DM+(wid>>2)*32+(lane&3)*8;
  const unsigned kdst=lds0+LDS_K+wid*1024, vdst=lds0+LDS_V+wid*1024;
  #define DMA_K(t,slot) glds16(ksrc+(long)(t)*KVBLK*DM,(unsigned)__builtin_amdgcn_readfirstlane(kdst+(slot)))
  #define DMA_V(t,slot) glds16(vsrc+(long)(t)*KVBLK*DM,(unsigned)__builtin_amdgcn_readfirstlane(vdst+(slot)))
  const int vb0=(int)(lds0+LDS_V)+((lane>>4)&1)*32+(lane&3)*8+(4*hi+((lane&15)>>2))*64;
  const char*Kbase=shm+LDS_K; bf16x8 kf[8];
  const lds_cptr shm3=(lds_cptr)shm; const lds_cptr kp0=shm3+LDS_K+hi*1024+r32*16; const lds_cptr vp0=shm3+LDS_V+((lane>>4)&1)*32+(lane&3)*8+(4*hi+((lane&15)>>2))*64;
  const int NT=4*qb+6-t0;
  DMA_K(0,0);DMA_V(0,0);DMA_K(1,SLOTB);
  bf16x8 qr[4];
  #pragma unroll
  for(int d0=0;d0<4;++d0)qr[d0]=*reinterpret_cast<const bf16x8*>(&Qw[(long)r32*DM+d0*16+hi*8]);
  float xm=cq,l_reg=0.f;f32x16 o[2];o[0]=f32x16{};o[1]=f32x16{};
  unsigned qa1,qa2;
  #define QASET() do{ unsigned p1_,p2_,p3_; split3(xm,p1_,p2_,p3_); qa1=hi?0u:(0x3F80u|(p1_<<16)); qa2=hi?0u:((p2_&0xffffu)|(p3_<<16)); }while(0)
  #define QAF(QA) do{ QA=__builtin_bit_cast(bf16x8,(u32x4){hi?0u:0x3F803F80u,qa1,qa2,0u}); }while(0)
  QASET();
  #define KAUG1(bv,KA) do{ unsigned a1_,a2_,a3_; split3((bv),a1_,a2_,a3_); \
      KA=__builtin_bit_cast(bf16x8,(u32x4){hi?0u:((a1_&0xffffu)|(a2_<<16)),hi?0u:((a3_&0xffffu)|0x3F800000u),hi?0u:0x3F803F80u,0u}); }while(0)
  float bcur=Bh[KVBLK+lane_s]; const float bt0=Bh[lane_s];
  const int qrel=wid*QBLK+r32;
  #define CMASK(P0,P1,t) do{int jb_=(t)-(NT-4); if(jb_>=0)cmask(P0,P1,jb_,qrel,hi);}while(0)
  bool resc=false;
  #define START(P0,P1) do{ const float rm=rowmax(P0,P1); resc=false; \
    { const float dl=rm; xm=fsub_s(xm,dl); QASET(); \
      _Pragma("unroll") for(int r=0;r<16;++r){P0[r]=fsub_s(P0[r],dl);P1[r]=fsub_s(P1[r],dl);} \
      } \
    _Pragma("unroll") for(int r=0;r<16;++r)P0[r]=__builtin_amdgcn_exp2f(P0[r]); }while(0)
  #define RESC() do{ if(resc){ asm volatile("s_waitcnt lgkmcnt(0)":::"memory"); \
      _Pragma("unroll") for(int d_=0;d_<2;++d_) _Pragma("unroll") for(int r=0;r<16;++r)o[d_][r]*=wsf[crow(r,hi)]; } }while(0)
  f32x16 pA0,pA1,pB0,pB1;
  int sl_prev=0,sl_cur=0,sl_next=SLOTB;
  #define ROT() do{sl_prev=sl_cur;sl_cur=sl_next;sl_next=(sl_next==(NSLOT-1)*SLOTB)?0:sl_next+SLOTB;}while(0)
  DMA_K(2,2*SLOTB);
  WAIT_BAR(3);
  { bf16x8 ka0_,ka1_,qa_; const float oth_=__shfl_xor(bt0,32); KAUG1(bt0,ka0_); KAUG1(oth_,ka1_); QAF(qa_); qkt(pA0,pA1,Kbase,qr,ka0_,ka1_,qa_,r32,hi); } asm volatile("s_nop 15\n\ts_nop 7":"+v"(pA0),"+v"(pA1));CMASK(pA0,pA1,0);
  START(pA0,pA1);
  _Pragma("unroll") for(int r=0;r<16;++r)pA1[r]=__builtin_amdgcn_exp2f(pA1[r]);
  WAIT_BAR(0);
  DMA_K(3,0);DMA_V(1,SLOTB);
  ROT();
  kload8(kf,kp0+sl_cur);
  WAIT_BAR(2);
  s16x4 vlo[8],vhi[8]; u32x4 pw0,pw1,pw2,pw3;
  #define BNEXT() do{ asm volatile("":"+v"(bcur)); }while(0)
  #define PKW(P,B) cvtpk_s(P[B],P[B+1])
  #define PAF(k) __builtin_bit_cast(bf16x8,pw##k)
  #define VFR(i) (bf16x8){vlo[i][0],vlo[i][1],vlo[i][2],vlo[i][3],vhi[i][0],vhi[i][1],vhi[i][2],vhi[i][3]}
  #define PIN(x) asm volatile("":"+v"(x))
  #define MX3(a,b,c) __builtin_fmaxf(__builtin_fmaxf((a),(b)),(c))
  #define GAPA(MF,A0,A1,A2,A3,W0,W1,PW) do{ MF; sacc+=A0; sacc+=A1; sacc+=A2; sacc+=A3; PIN(sacc); W0; W1; PIN(PW); SBAR(); }while(0)
  #define EX(v) __builtin_amdgcn_exp2f(v)
  #define GAPB(MF,X,B) do{ MF; X[B]=EX(X[B]); X[B+1]=EX(X[B+1]); X[B+2]=EX(X[B+2]); X[B+3]=EX(X[B+3]); PIN(X); SBAR(); }while(0)
  #define VRD(i) do{ vlo[i]=vtr(vp_+(((i)>>2)*4096+((i)&3)*1024)); vhi[i]=vtr(vp_+(((i)>>2)*4096+((i)&3)*1024+512)); }while(0)
  #define KRD(G,j) do{ if(G){ kload2(kf,kp0+sl_next,j); SBAR(); } }while(0)
  #define STEP(C0,C1,P0,P1,t,GK,GV,GL) do{ SBAR(); \
    const lds_cptr vp_=vp0+sl_prev; \
    { bf16x8 ka_,qa_; QAF(qa_); const float oth_=__shfl_xor(bcur,32); KAUG1(bcur,ka_); \
      if(GV){ asm volatile("global_load_dword %0, %1, off":"=v"(bcur):"v"(Bh+(long)((t)+1)*KVBLK+lane):"memory"); } \
      SBAR(); C0=__builtin_amdgcn_mfma_f32_32x32x16_bf16(ka_,qa_,f32x16{},0,0,0); SBAR(); KAUG1(oth_,ka_); C1=__builtin_amdgcn_mfma_f32_32x32x16_bf16(ka_,qa_,f32x16{},0,0,0); SBAR(); } \
    VRD(0); SBAR(); float sacc=(P0[0]+P0[1]); \
    GAPA(C0=__builtin_amdgcn_mfma_f32_32x32x16_bf16(kf[0],qr[0],C0,0,0,0), P0[2],P0[3],P0[4],P0[5],     pw0[0]=PKW(P0,0), pw0[1]=PKW(P0,2), pw0); \
    VRD(4); SBAR(); GAPA(C1=__builtin_amdgcn_mfma_f32_32x32x16_bf16(kf[1],qr[0],C1,0,0,0), P0[6],P0[7],P0[8],P0[9],     pw0[2]=PKW(P0,4), pw0[3]=PKW(P0,6), pw0); \
    VRD(1); SBAR(); GAPA(C0=__builtin_amdgcn_mfma_f32_32x32x16_bf16(kf[2],qr[1],C0,0,0,0),   P0[10],P0[11],P0[12],P0[13], pw1[0]=PKW(P0,8), pw1[1]=PKW(P0,10), pw1); \
    VRD(5); SBAR(); GAPA(C1=__builtin_amdgcn_mfma_f32_32x32x16_bf16(kf[3],qr[1],C1,0,0,0),   P0[14],P0[15],P1[0],P1[1],   pw1[2]=PKW(P0,12),pw1[3]=PKW(P0,14), pw1); \
    VRD(2); SBAR(); GAPA(C0=__builtin_amdgcn_mfma_f32_32x32x16_bf16(kf[4],qr[2],C0,0,0,0),   P1[2],P1[3],P1[4],P1[5],     pw2[0]=PKW(P1,0), pw2[1]=PKW(P1,2), pw2); \
    VRD(6); SBAR(); GAPA(C1=__builtin_amdgcn_mfma_f32_32x32x16_bf16(kf[5],qr[2],C1,0,0,0),   P1[6],P1[7],P1[8],P1[9],     pw2[2]=PKW(P1,4), pw2[3]=PKW(P1,6), pw2); \
    VRD(3); SBAR(); GAPA(C0=__builtin_amdgcn_mfma_f32_32x32x16_bf16(kf[6],qr[3],C0,0,0,0),   P1[10],P1[11],P1[12],P1[13], pw3[0]=PKW(P1,8), pw3[1]=PKW(P1,10), pw3); \
    VRD(7); SBAR(); GAPA(C1=__builtin_amdgcn_mfma_f32_32x32x16_bf16(kf[7],qr[3],C1,0,0,0),   P1[14],P1[15],0.f,0.f,       pw3[2]=PKW(P1,12),pw3[3]=PKW(P1,14), pw3); \
    l_reg+=sacc; \
    if(GK){DMA_K((t)+3,sl_cur);} if(GV){DMA_V((t)+1,sl_next);} \
    CMASK(C0,C1,t); \
    { float a=MX3(C0[0],C0[1],C1[0]),b=MX3(C0[2],C0[3],C1[1]); a=MX3(a,C1[2],C1[3]); \
      _Pragma("unroll") for(int r=4;r<16;r+=4){a=MX3(a,C0[r],C0[r+1]);b=MX3(b,C0[r+2],C0[r+3]);a=MX3(a,C1[r],C1[r+1]);b=MX3(b,C1[r+2],C1[r+3]);} \
      float rm=__builtin_fmaxf(a,b); { auto rr=__builtin_amdgcn_permlane32_swap(__float_as_uint(rm),__float_as_uint(rm),false,false); rm=__builtin_fmaxf(__uint_as_float(rr[0]),__uint_as_float(rr[1])); } \
      resc=false; \
      if(__builtin_expect(__any(rm>(float)THRL),0)){ const float dl=__builtin_fmaxf(rm,0.f); xm-=dl; QASET(); \
        _Pragma("unroll") for(int r=0;r<16;++r){C0[r]-=dl;C1[r]-=dl;} \
        const float f=__builtin_amdgcn_exp2f(-dl); l_reg*=f; if(hi==0)wsf[r32]=f; resc=true; } } \
    SBAR(); \
    GAPB(o[0]=__builtin_amdgcn_mfma_f32_32x32x16_bf16(PAF(0),VFR(0),o[0],0,0,0), C0,0); \
    GAPB(o[1]=__builtin_amdgcn_mfma_f32_32x32x16_bf16(PAF(0),VFR(4),o[1],0,0,0), C0,4); \
    KRD(GL,0); GAPB(o[0]=__builtin_amdgcn_mfma_f32_32x32x16_bf16(PAF(1),VFR(1),o[0],0,0,0), C0,8); \
    KRD(GL,1); GAPB(o[1]=__builtin_amdgcn_mfma_f32_32x32x16_bf16(PAF(1),VFR(5),o[1],0,0,0), C0,12); \
    KRD(GL,2); GAPB(o[0]=__builtin_amdgcn_mfma_f32_32x32x16_bf16(PAF(2),VFR(2),o[0],0,0,0), C1,0); \
    KRD(GL,3); GAPB(o[1]=__builtin_amdgcn_mfma_f32_32x32x16_bf16(PAF(2),VFR(6),o[1],0,0,0), C1,4); \
    GAPB(o[0]=__builtin_amdgcn_mfma_f32_32x32x16_bf16(PAF(3),VFR(3),o[0],0,0,0), C1,8); \
    GAPB(o[1]=__builtin_amdgcn_mfma_f32_32x32x16_bf16(PAF(3),VFR(7),o[1],0,0,0), C1,12); \
    }while(0)
  int t=1;
  #undef CMASK
  #define CMASK(P0,P1,t) do{}while(0)
  for(;t+5<NT;t+=2){
    STEP(pB0,pB1,pA0,pA1,t,true,true,true);     WAIT_BAR(2); BNEXT(); RESC(); ROT();
    STEP(pA0,pA1,pB0,pB1,t+1,true,true,true);   WAIT_BAR(2); BNEXT(); RESC(); ROT();
  }
  #undef CMASK
  #define CMASK(P0,P1,t) do{int jb_=(t)-(NT-4); if(jb_>=0)cmask(P0,P1,jb_,qrel,hi);}while(0)
  #define ENDW(tt) do{ if((tt)+3<NT){WAIT_BAR(2);} else if((tt)+2<NT){WAIT_BAR(1);} else {WAIT_BAR(0);} }while(0)
  for(;t+1<NT;t+=2){
    STEP(pB0,pB1,pA0,pA1,t,(t+3<NT),(t+1<NT),(t+1<NT));       ENDW(t);   BNEXT(); RESC(); ROT();
    STEP(pA0,pA1,pB0,pB1,t+1,(t+4<NT),(t+2<NT),(t+2<NT));     ENDW(t+1); BNEXT(); RESC(); ROT();
  }
  STEP(pB0,pB1,pA0,pA1,NT-1,false,false,false); RESC();
  { float sacc=pB0[0]+pB0[1]; _Pragma("unroll") for(int r=2;r<16;++r)sacc+=pB0[r]; _Pragma("unroll") for(int r=0;r<16;++r)sacc+=pB1[r]; l_reg+=sacc;
    pw0=(u32x4){PKW(pB0,0),PKW(pB0,2),PKW(pB0,4),PKW(pB0,6)};pw1=(u32x4){PKW(pB0,8),PKW(pB0,10),PKW(pB0,12),PKW(pB0,14)};pw2=(u32x4){PKW(pB1,0),PKW(pB1,2),PKW(pB1,4),PKW(pB1,6)};pw3=(u32x4){PKW(pB1,8),PKW(pB1,10),PKW(pB1,12),PKW(pB1,14)};
    SBAR(); pv(o,vb0+sl_cur,PAF(0),PAF(1),PAF(2),PAF(3)); }
  #undef PKW
  #undef PAF
  #undef VFR
  #undef PIN
  #undef MX3
  #undef GAPA
  #undef GAPB
  #undef EX
  #undef VRD
  #undef KRD
  #undef STEP
  #undef ENDW
  {auto rr=__builtin_amdgcn_permlane32_swap(__float_as_uint(l_reg),__float_as_uint(l_reg),false,false);l_reg=__uint_as_float(rr[0])+__uint_as_float(rr[1]);}
  if(hi==0)wsf[32+r32]=l_reg;asm volatile("s_waitcnt lgkmcnt(0)":::"memory");
  float rli[16];
  #pragma unroll
  for(int r=0;r<16;++r)rli[r]=__builtin_amdgcn_rcpf(wsf[32+crow(r,hi)]);
  bf16*Ow=O+(rowbase+q0+wid*QBLK)*DM+h*D;
  { bf16*stg=(bf16*)(shm+LDS_OST)+wid*2048;
    #pragma unroll
    for(int r=0;r<16;++r){const int orow=crow(r,hi);
      #pragma unroll
      for(int d0=0;d0<2;++d0)stg[orow*64+d0*32+r32]=__float2bfloat16(o[d0][r]*rli[r]);}
    asm volatile("s_waitcnt lgkmcnt(0)":::"memory");
    const bf16*Gw=GATE+(rowbase+q0+wid*QBLK)*DM+h*D;
    #pragma unroll
    for(int i=0;i<4;++i){const int row=i*8+(lane>>3),ch=lane&7; const u32x4 v=*(const u32x4*)(stg+row*64+ch*8); const u32x4 g=*(const u32x4*)(Gw+(long)row*DM+ch*8); u32x4 w;
      #pragma unroll
      for(int e=0;e<4;++e){ const float lo=__uint_as_float(v[e]<<16)*__uint_as_float(g[e]<<16), hh=__uint_as_float(v[e]&0xffff0000u)*__uint_as_float(g[e]&0xffff0000u); w[e]=cvtpk_s(lo,hh); }
      ATTN_STORE16(Ow+(long)row*DM+ch*8,w);} }
  asm volatile("s_waitcnt lgkmcnt(0)\n\ts_barrier":::"memory");
  #undef DMA_K
  #undef DMA_V
  #undef CMASK
  #undef START
  #undef RESC
  #undef ROT
}
constexpr int ATTN_LDS_BYTES=LDS_BYTES;
struct AttnTensors { const bf16* Q; const bf16* K; const bf16* V; bf16* O; const float* BIAS; const bf16* GATE; float skipc; const int* T0; };
struct AttnUnit { int bh; int qb; };
struct StaticOrder {
  int vcu;
  __device__ __forceinline__ explicit StaticOrder(int grid,int block):vcu((block%8)*(grid/8)+block/8){}
  __device__ __forceinline__ bool next(int i,AttnUnit&u)const{ if(i>=4)return false; const int s=vcu&7; u.bh=vcu>>3; u.qb=(i==0)?s:(i==1)?15-s:(i==2)?16+s:31-s; return true; }
  __device__ __forceinline__ void a_ready(const AttnUnit&)const{}
  __device__ __forceinline__ void done(const AttnUnit&)const{}
};
template<class Sched,int THRL=8> __device__ __forceinline__ void attn_phase(char*lds,const AttnTensors&T,const Sched&S,const int tid_in){
  AttnUnit u,un;
  if(!S.next(0,u))return;
  int t0n=T.T0[u.bh*32+u.qb];
  for(int i=0;;++i){ const int t0=t0n; const bool more=S.next(i+1,un); if(more)t0n=T.T0[un.bh*32+un.qb];
    S.a_ready(u); attn_unit<THRL>(u.bh/NHEAD,u.bh%NHEAD,u.qb,T.Q,T.K,T.V,T.O,T.BIAS,T.GATE,t0,lds,tid_in); S.done(u); if(!more)break; u=un; }
}
#undef SBAR
#undef WAIT_BAR
}

namespace hg {
#define LDS_BAR() asm volatile("s_waitcnt lgkmcnt(0)\n\ts_barrier" ::: "memory")
typedef short v4i16_t __attribute__((ext_vector_type(4)));
constexpr int PT = 72, PV = 136;
constexpr int O_QH = 0, O_QT = 18432, O_KT = 36864, O_KP = 55296, O_VT = 73728, O_SC = 91136, O_SEG = 100352  , O_DEC = 104448, O_PART = 104960, O_END = 107008;
constexpr int O_OT = O_QT;
constexpr int NSC = 16, SCTOK = SEQ / NSC;

__device__ __forceinline__ bf16x8 tr_frag(const LAS unsigned char* img, int pitchB, int ka, int kb, int col0, int fr) {
    const LAS unsigned char* p = img + (fr >> 2) * pitchB + (col0 + 4 * (fr & 3)) * 2;
    const v4i16_t a = __builtin_amdgcn_ds_read_tr16_b64_v4i16((LAS v4i16_t*)(p + ka * pitchB));
    const v4i16_t b = __builtin_amdgcn_ds_read_tr16_b64_v4i16((LAS v4i16_t*)(p + kb * pitchB));
    return (bf16x8){a[0], a[1], a[2], a[3], b[0], b[1], b[2], b[3]};
}

struct UnitCtx { const bf16_t* QH; const _Float16* LF; const bf16_t* VH; const bf16_t* G; bf16_t* OH; const float* MW; const float* MSSQ; const float* lbt; const float* og; bf16_t* MA; };
struct ChunkRegs { unsigned lf2[8]; unsigned qs2[8]; v4u v[2]; };
__device__ __forceinline__ float h2f_lo(unsigned u) { return (float)__builtin_bit_cast(_Float16, (unsigned short)(u & 0xffffu)); }
__device__ __forceinline__ float h2f_hi(unsigned u) { return (float)__builtin_bit_cast(_Float16, (unsigned short)(u >> 16)); }
__device__ __forceinline__ unsigned f2h2(float a, float b) { return (unsigned)__builtin_bit_cast(unsigned short, (_Float16)a) | ((unsigned)__builtin_bit_cast(unsigned short, (_Float16)b) << 16); }

template <bool OUT> __device__ __forceinline__ void load_main(ChunkRegs& R, const UnitCtx& C, int row0, int cb, int tid) {
    const int kp = tid & 63, te = tid >> 6;
    const unsigned* lf = (const unsigned*)(C.LF + (size_t)(row0 + 8 * te) * D + cb) + kp; const unsigned* qh = (const unsigned*)(C.QH + (size_t)(row0 + 8 * te) * D + cb) + kp;
#pragma unroll
    for (int j = 0; j < 8; ++j) { R.lf2[j] = lf[(size_t)j * (D / 2)]; R.qs2[j] = OUT ? qh[(size_t)j * (D / 2)] : 0u; }
#pragma unroll
    for (int i = 0; i < 2; ++i) { const int p = tid + NTHREADS * i, row = p >> 4, ch = p & 15; R.v[i] = *(const v4u*)(C.VH + (size_t)(row0 + row) * D + cb + 8 * ch); }
}
__device__ __forceinline__ void load_meta(ChunkRegs& R, v4u (&g)[2], const UnitCtx& C, int cb, int tid) {
    const int kp = tid & 63, te = tid >> 6, k0 = cb + 2 * kp;
    const float lba = C.lbt[k0], lbb = C.lbt[k0 + 1];
#pragma unroll
    for (int j = 0; j < 8; ++j) {
        const int t = 8 * te + j;
        if (te < 2) { const float rs = rsqrtf(C.MSSQ[t] * (1.f / D) + EPS); const float* mr = C.MW + (size_t)t * 4 * D + k0;
            const float qa = rs * mr[0], qb = rs * mr[1];
            R.lf2[j] = f2h2(__logf(lba + (1.f - lba) * sigm(rs * mr[D])), __logf(lbb + (1.f - lbb) * sigm(rs * mr[D + 1]))); R.qs2[j] = pk2(qa * sigm(qa), qb * sigm(qb)); }
        else { R.lf2[j] = 0u; R.qs2[j] = 0u; }
    }
#pragma unroll
    for (int i = 0; i < 2; ++i) {
        const int p = tid + NTHREADS * i, row = p >> 4, ch = p & 15; R.v[i] = (v4u){0u, 0u, 0u, 0u}; g[i] = (v4u){0u, 0u, 0u, 0u};
        if (row < NMETA) { const float rs = rsqrtf(C.MSSQ[row] * (1.f / D) + EPS); const float* mr = C.MW + (size_t)row * 4 * D + 2 * D + cb + 8 * ch; float x[8], y[8];
#pragma unroll
            for (int e = 0; e < 8; ++e) { x[e] = rs * mr[e]; y[e] = sigm(rs * mr[D + e]); }
            R.v[i] = pack8(x); g[i] = pack8(y); }
    }
}

template <bool OUT, bool META> __device__ __forceinline__ void chunk(Frame& F, const UnitCtx& C, f32x4 (&S)[8], float (&logdec)[2], ChunkRegs& R, v4u (&gm)[2], int row0, int next_row0, int cb, bool write_meta) {
    LAS unsigned char* lds = F.lds;
    LAS bf16_t* QHs = (LAS bf16_t*)(lds + O_QH); LAS bf16_t* QTs = (LAS bf16_t*)(lds + O_QT); LAS bf16_t* KTs = (LAS bf16_t*)(lds + O_KT);
    LAS bf16_t* VTs = (LAS bf16_t*)(lds + O_VT); LAS bf16_t* KPs = (LAS bf16_t*)(lds + O_KP); LAS bf16_t* SCs = (LAS bf16_t*)(lds + O_SC); LAS bf16_t* OTs = (LAS bf16_t*)(lds + O_OT);
    LAS float* SEG = (LAS float*)(lds + O_SEG); LAS float* DEC = (LAS float*)(lds + O_DEC); LAS float* PART = (LAS float*)(lds + O_PART);
    int lane_l = F.lane; asm volatile("" : "+v"(lane_l));
    const int lane = lane_l, w = F.wave, tid = w * 64 + lane, fr = lane & 15, fq = lane >> 4;
    const int kp = lane, te = w;

    v4u g[2];
    if (OUT) {
#pragma unroll
        for (int i = 0; i < 2; ++i) { const int p = tid + NTHREADS * i, row = p >> 4, ch = p & 15; g[i] = META ? gm[i] : *(const v4u*)(C.G + (size_t)(row0 + row) * D + cb + 8 * ch); }
    }
    float lfa[8], lfb[8], pa[8], pb[8]; float runa = 0.f, runb = 0.f;
#pragma unroll
    for (int j = 0; j < 8; ++j) { lfa[j] = h2f_lo(R.lf2[j]); lfb[j] = h2f_hi(R.lf2[j]); runa += lfa[j]; runb += lfb[j]; pa[j] = runa; pb[j] = runb; }
    typedef float f32x2l __attribute__((ext_vector_type(2)));
    *(LAS f32x2l*)(SEG + te * 128 + 2 * kp) = (f32x2l){runa, runb};
    LDS_BAR();
    {
        float offa = 0.f, offb = 0.f, bma = 0.f, bmb = 0.f, benda = 0.f, bendb = 0.f;
#pragma unroll
        for (int q = 0; q < 8; ++q) { const f32x2l s = *(const LAS f32x2l*)(SEG + q * 128 + 2 * kp); if (q < te) { offa += s.x; offb += s.y; } if (q < 4) { bma += s.x; bmb += s.y; } benda += s.x; bendb += s.y; }
        if (te == 0) { *(LAS f32x2l*)(DEC + 2 * kp) = (f32x2l){__expf(benda), __expf(bendb)}; logdec[0] += benda; logdec[1] += bendb; }
        const float c1a = __expf(bma), c1b = __expf(bmb), c2a = __expf(benda - bma), c2b = __expf(bendb - bmb);
        float qta[8], kta[8], qtb[8], ktb[8];
#pragma unroll
        for (int j = 0; j < 8; ++j) {
            const float Ea = __expf(offa + pa[j] - bma), Eb = __expf(offb + pb[j] - bmb);
            qta[j] = __uint_as_float(R.qs2[j] << 16) * Ea; qtb[j] = __uint_as_float(R.qs2[j] & 0xffff0000u) * Eb;
            kta[j] = (1.f - __expf(lfa[j])) * __builtin_amdgcn_rcpf(Ea); ktb[j] = (1.f - __expf(lfb[j])) * __builtin_amdgcn_rcpf(Eb);
        }
        const int oa = (2 * kp) * PT + 8 * te, ob = oa + PT;
        float t8[8];
        if (OUT) {
            *(LAS v4u*)(QTs + oa) = pack8(qta); *(LAS v4u*)(QTs + ob) = pack8(qtb);
            *(LAS v4u*)(KTs + oa) = pack8(kta); *(LAS v4u*)(KTs + ob) = pack8(ktb);
#pragma unroll
            for (int e = 0; e < 8; ++e) t8[e] = qta[e] * c1a;
            *(LAS v4u*)(QHs + oa) = pack8(t8);
#pragma unroll
            for (int e = 0; e < 8; ++e) t8[e] = qtb[e] * c1b;
            *(LAS v4u*)(QHs + ob) = pack8(t8);
        }
#pragma unroll
        for (int e = 0; e < 8; ++e) t8[e] = kta[e] * c2a;
        *(LAS v4u*)(KPs + oa) = pack8(t8);
#pragma unroll
        for (int e = 0; e < 8; ++e) t8[e] = ktb[e] * c2b;
        *(LAS v4u*)(KPs + ob) = pack8(t8);
    }
#pragma unroll
    for (int i = 0; i < 2; ++i) { const int p = tid + NTHREADS * i, row = p >> 4, ch = p & 15; *(LAS v4u*)(VTs + row * PV + 8 * ch) = R.v[i]; }
    LDS_BAR();

    if (!META && next_row0 >= 0) load_main<OUT>(R, C, next_row0, cb, tid);

    bf16x8 vf[2];
    vf[0] = tr_frag((const LAS unsigned char*)VTs, PV * 2, 8 * fq, 8 * fq + 4, 16 * w, fr); vf[1] = tr_frag((const LAS unsigned char*)VTs, PV * 2, 32 + 8 * fq, 32 + 8 * fq + 4, 16 * w, fr);
    if (OUT) {
#pragma unroll
        for (int bb = 0; bb < 2; ++bb) {
            const int bi = 2 * w + bb, tb = bi >> 2, sb = bi & 3;
            f32x4 c = (f32x4){0.f, 0.f, 0.f, 0.f};
            if (sb <= tb) {
#pragma unroll
                for (int ks = 0; ks < 4; ++ks) { const bf16x8 a = tr_frag((const LAS unsigned char*)QTs, PT * 2, 32 * ks + 8 * fq, 32 * ks + 8 * fq + 4, 16 * tb, fr), b = tr_frag((const LAS unsigned char*)KTs, PT * 2, 32 * ks + 8 * fq, 32 * ks + 8 * fq + 4, 16 * sb, fr);
                    c = __builtin_amdgcn_mfma_f32_16x16x32_bf16(a, b, c, 0, 0, 0); }
            }
#pragma unroll
            for (int e = 0; e < 4; ++e) { const int t = 16 * tb + 4 * fq + e, s = 16 * sb + fr; SCs[t * PT + s] = (bf16_t)f2bf(s <= t ? c[e] : 0.f); }
        }
        LDS_BAR();

        bf16x8 sfr[4];
#pragma unroll
        for (int ks = 0; ks < 4; ++ks) { const f32x4 x0 = S[2 * ks], x1 = S[2 * ks + 1]; const v4u wv = (v4u){pk2(x0[0], x0[1]), pk2(x0[2], x0[3]), pk2(x1[0], x1[1]), pk2(x1[2], x1[3])}; sfr[ks] = __builtin_bit_cast(bf16x8, wv); }
        f32x4 o[4];
#pragma unroll
        for (int tb = 0; tb < 4; ++tb) {
            o[tb] = (f32x4){0.f, 0.f, 0.f, 0.f};
#pragma unroll
            for (int ks = 0; ks < 2; ++ks) { const bf16x8 a = *(const LAS bf16x8*)(SCs + (16 * tb + fr) * PT + 32 * ks + 8 * fq); o[tb] = __builtin_amdgcn_mfma_f32_16x16x32_bf16(a, vf[ks], o[tb], 0, 0, 0); }
#pragma unroll
            for (int ks = 0; ks < 4; ++ks) { const bf16x8 a = tr_frag((const LAS unsigned char*)QHs, PT * 2, 32 * ks + 4 * fq, 32 * ks + 16 + 4 * fq, 16 * tb, fr); o[tb] = __builtin_amdgcn_mfma_f32_16x16x32_bf16(a, sfr[ks], o[tb], 0, 0, 0); }
        }
#pragma unroll
        for (int tb = 0; tb < 4; ++tb)
#pragma unroll
            for (int e = 0; e < 4; ++e) OTs[(16 * tb + 4 * fq + e) * PV + 16 * w + fr] = (bf16_t)f2bf(o[tb][e]);
        LDS_BAR();

#pragma unroll
        for (int i = 0; i < 2; ++i) {
            const int p = tid + NTHREADS * i, row = p >> 4, ch = p & 15;
            float ov[8], gv[8]; unpack8(*(const LAS v4u*)(OTs + row * PV + 8 * ch), ov); unpack8(g[i], gv);
            float q = 0.f;
#pragma unroll
            for (int e = 0; e < 8; ++e) q += ov[e] * ov[e];
            q = row16_sum(q);
            const float rsn = rsqrtf(q * (1.f / DK) + EPS);
            const f32x4 g0 = *(const f32x4*)(C.og + 8 * ch), g1 = *(const f32x4*)(C.og + 8 * ch + 4);
#pragma unroll
            for (int e = 0; e < 8; ++e) ov[e] = ov[e] * rsn * (e < 4 ? g0[e & 3] : g1[e & 3]) * gv[e];
            if (!META) *(v4u*)(C.OH + (size_t)(row0 + row) * D + cb + 8 * ch) = pack8(ov);
            else if (write_meta && row < NMETA) *(v4u*)(C.MA + (size_t)row * D + cb + 8 * ch) = pack8(ov);
        }
    }

#pragma unroll
    for (int mb = 0; mb < 8; ++mb) {
        const f32x4 dv4 = *(const LAS f32x4*)(DEC + 16 * mb + 4 * fq);
        S[mb] = S[mb] * dv4;
#pragma unroll
        for (int ks = 0; ks < 2; ++ks) { const bf16x8 a = *(const LAS bf16x8*)(KPs + (16 * mb + fr) * PT + 32 * ks + 8 * fq); S[mb] = __builtin_amdgcn_mfma_f32_16x16x32_bf16(a, vf[ks], S[mb], 0, 0, 0); }
    }

}

constexpr int P1K = 264, O1_KP = 0, O1_VT = 128 * P1K * 2, O1_DEC = O1_VT + 256 * PV * 2, O1_BS = O1_DEC + 2048, O1_END = O1_BS + 4096;
static_assert(O1_END <= 147456 - 256, "pass-1 LDS map");
__device__ __forceinline__ void superchunk_state(Frame& F, const UnitCtx& C, f32x4 (&S)[8], float (&logdec)[2], int row0, int cb) {
    LAS unsigned char* lds = F.lds;
    LAS bf16_t* KPs = (LAS bf16_t*)(lds + O1_KP); LAS bf16_t* VTs = (LAS bf16_t*)(lds + O1_VT); LAS float* DEC = (LAS float*)(lds + O1_DEC); LAS float* BS = (LAS float*)(lds + O1_BS);
    int lane_l = F.lane; asm volatile("" : "+v"(lane_l));
    const int lane = lane_l, w = F.wave, tid = w * 64 + lane, fr = lane & 15, fq = lane >> 4;
    const int kp = lane, c = w >> 1, hf = w & 1;
    typedef float f32x2l __attribute__((ext_vector_type(2)));
    v4u vv[8];
#pragma unroll
    for (int i = 0; i < 8; ++i) { const int p = tid + NTHREADS * i, row = p >> 4, ch = p & 15; vv[i] = *(const v4u*)(C.VH + (size_t)(row0 + row) * D + cb + 8 * ch); }
    const unsigned* lf = (const unsigned*)(C.LF + (size_t)(row0 + 32 * w) * D + cb) + kp;
    unsigned lf2[32];
#pragma unroll
    for (int j = 0; j < 32; ++j) lf2[j] = lf[(size_t)j * (D / 2)];
    float ha = 0.f, hb = 0.f;
#pragma unroll
    for (int j = 0; j < 32; ++j) { ha += h2f_lo(lf2[j]); hb += h2f_hi(lf2[j]); }
    *(LAS f32x2l*)(BS + w * 128 + 2 * kp) = (f32x2l){ha, hb};
#pragma unroll
    for (int i = 0; i < 8; ++i) { const int p = tid + NTHREADS * i, row = p >> 4, ch = p & 15; *(LAS v4u*)(VTs + row * PV + 8 * ch) = vv[i]; }
    LDS_BAR();
    {
        const f32x2l s0 = *(const LAS f32x2l*)(BS + (2 * c) * 128 + 2 * kp), s1 = *(const LAS f32x2l*)(BS + (2 * c + 1) * 128 + 2 * kp);
        const float benda = s0.x + s1.x, bendb = s0.y + s1.y;
        if (hf == 0) *(LAS f32x2l*)(DEC + c * 128 + 2 * kp) = (f32x2l){__expf(benda), __expf(bendb)};
        float ra = hf ? s0.x : 0.f, rb = hf ? s0.y : 0.f;
#pragma unroll
        for (int g8 = 0; g8 < 4; ++g8) {
            float ta[8], tb[8];
#pragma unroll
            for (int j = 0; j < 8; ++j) { const float la = h2f_lo(lf2[8 * g8 + j]), lb = h2f_hi(lf2[8 * g8 + j]); ra += la; rb += lb;
                ta[j] = (1.f - __expf(la)) * __expf(benda - ra); tb[j] = (1.f - __expf(lb)) * __expf(bendb - rb); }
            *(LAS v4u*)(KPs + (2 * kp) * P1K + 32 * w + 8 * g8) = pack8(ta);
            *(LAS v4u*)(KPs + (2 * kp + 1) * P1K + 32 * w + 8 * g8) = pack8(tb);
        }
    }
    LDS_BAR();
    if (w == 0) {
#pragma unroll
        for (int q = 0; q < 8; ++q) { const f32x2l s = *(const LAS f32x2l*)(BS + q * 128 + 2 * lane); logdec[0] += s.x; logdec[1] += s.y; }
    }
#pragma unroll
    for (int cc = 0; cc < 4; ++cc) {
#pragma unroll
        for (int mb = 0; mb < 8; ++mb) { const f32x4 dv4 = *(const LAS f32x4*)(DEC + cc * 128 + 16 * mb + 4 * fq); S[mb] = S[mb] * dv4; }
#pragma unroll
        for (int ks = 0; ks < 2; ++ks) {
            const int t0 = 64 * cc + 32 * ks;
            const bf16x8 vf = tr_frag((const LAS unsigned char*)VTs, PV * 2, t0 + 8 * fq, t0 + 8 * fq + 4, 16 * w, fr);
#pragma unroll
            for (int mb = 0; mb < 8; ++mb) { const bf16x8 a = *(const LAS bf16x8*)(KPs + (16 * mb + fr) * P1K + t0 + 8 * fq); S[mb] = __builtin_amdgcn_mfma_f32_16x16x32_bf16(a, vf, S[mb], 0, 0, 0); }
        }
    }
    LDS_BAR();
}

template <bool OUT> __device__ __forceinline__ void unit(Frame& F, const UnitCtx& C, int u, float* ST, float* DECG) {
    const int bh = u / NSC, sc = u % NSC, b = bh >> 3, h = bh & 7, cb = h * DK, row_sc = b * SEQ + SCTOK * sc;
    int lane_l = F.lane; asm volatile("" : "+v"(lane_l));
    const int lane = lane_l, w = F.wave, tid = w * 64 + lane, fr = lane & 15, fq = lane >> 4;
    bf16_t* st = (bf16_t*)ST + (size_t)u * DK * DK + (size_t)(16 * w + fr) * DK + 32 * fq;
    f32x4 S[8]; float logdec[2] = {0.f, 0.f};
    if (OUT) {
        v4u sw[4];
#pragma unroll
        for (int q = 0; q < 4; ++q) sw[q] = *(const v4u*)(st + 8 * q);
#pragma unroll
        for (int q = 0; q < 4; ++q) {
            S[2 * q] = (f32x4){__uint_as_float(sw[q].x << 16), __uint_as_float(sw[q].x & 0xffff0000u), __uint_as_float(sw[q].y << 16), __uint_as_float(sw[q].y & 0xffff0000u)};
            S[2 * q + 1] = (f32x4){__uint_as_float(sw[q].z << 16), __uint_as_float(sw[q].z & 0xffff0000u), __uint_as_float(sw[q].w << 16), __uint_as_float(sw[q].w & 0xffff0000u)}; }
    } else {
#pragma unroll
        for (int mb = 0; mb < 8; ++mb) S[mb] = (f32x4){0.f, 0.f, 0.f, 0.f};
    }
    ChunkRegs R; v4u gm[2] = {(v4u){0u, 0u, 0u, 0u}, (v4u){0u, 0u, 0u, 0u}};
    if (sc == 0) { load_meta(R, gm, C, cb, tid); chunk<OUT, true>(F, C, S, logdec, R, gm, 0, -1, cb, b == 0); }
    if (!OUT) { for (int q = 0; q < SCTOK / 256; ++q) superchunk_state(F, C, S, logdec, row_sc + 256 * q, cb); }
    else {
        load_main<OUT>(R, C, row_sc, cb, tid);
        for (int c = 0; c < SCTOK / 64; ++c) chunk<OUT, false>(F, C, S, logdec, R, gm, row_sc + 64 * c, c < SCTOK / 64 - 1 ? row_sc + 64 * (c + 1) : -1, cb, false);
    }
    if (!OUT) {
#pragma unroll
        for (int q = 0; q < 4; ++q) *(v4u*)(st + 8 * q) = (v4u){pk2(S[2 * q][0], S[2 * q][1]), pk2(S[2 * q][2], S[2 * q][3]), pk2(S[2 * q + 1][0], S[2 * q + 1][1]), pk2(S[2 * q + 1][2], S[2 * q + 1][3])};
        if (w == 0) { DECG[(size_t)u * DK + 2 * lane] = __expf(logdec[0]); DECG[(size_t)u * DK + 2 * lane + 1] = __expf(logdec[1]); }
    }
    __syncthreads();
}
__device__ __forceinline__ void scan(Frame& F, float* ST, const float* __restrict__ DECG) {
    typedef float f32x2s __attribute__((ext_vector_type(2)));
    const int gid = F.bid * NTHREADS + F.tid, nthr = F.G * NTHREADS;
    for (int e = gid; e < NB * HH * DK * DK / 2; e += nthr) {
        const int bh = e >> 13, idx2 = e & 8191, pos = (2 * idx2) & 127, dk = 16 * ((pos >> 2) & 7) + 4 * (pos >> 5) + (pos & 3);
        unsigned* p = (unsigned*)ST + (size_t)bh * NSC * (DK * DK / 2) + idx2; const float* dp = DECG + (size_t)bh * NSC * DK + dk;
        unsigned uu[NSC]; f32x2s dd[NSC];
#pragma unroll
        for (int sc = 0; sc < NSC; ++sc) { uu[sc] = p[(size_t)sc * (DK * DK / 2)]; dd[sc] = *(const f32x2s*)(dp + sc * DK); }
        float s0 = 0.f, s1 = 0.f;
#pragma unroll
        for (int sc = 0; sc < NSC; ++sc) { p[(size_t)sc * (DK * DK / 2)] = pk2(s0, s1); s0 = dd[sc].x * s0 + __uint_as_float(uu[sc] << 16); s1 = dd[sc].y * s1 + __uint_as_float(uu[sc] & 0xffff0000u); }
    }
}
}

enum { PH_PRO = 0, PH_FOXIN, PH_SCAN, PH_ATTN, PH_FOXOUT, PH_GATE0, PH_UP0, PH_DOWN0, PH_HGIN, PH_HG1, PH_HG2, PH_HG3, PH_HGOUT, PH_GATE1, PH_UP1, PH_DOWN1, NPH,
       PH_T_FFNPREP0 = 32, PH_T_FFNPREP1 = 33, PH_T_FFNPOST = 34, PH_T_FOXPOST = 35, PH_T_HGPREP = 36, PH_T_HGPOST = 37 };
struct Args { const float* in[19]; float* out; unsigned char* ws; int ph_lo, ph_hi, pad0, pad1; };
enum { I_X = 0, I_META, I_FOXNORM, I_FOXWIN, I_FOXBF, I_FOXQG, I_FOXKG, I_FOXWOUT, I_HGNORM, I_HGWIN, I_HGLB, I_HGOG, I_HGWOUT, I_FFNNORM, I_FFNWG, I_FFNWU, I_FFNCW, I_FFNCB, I_FFNWD };

template <bool ABF16> __device__ __forceinline__ void side_gemm_wg(Frame& F, const void* A1, const float* A2, const bf16_t* Wt, int N, int K, float* out, int hidx, int nh) {
    const int lane = F.lane, fr = lane & 15, fq = lane >> 4, steps = K / 32 / NWAVES;
    LAS f32x4* red = (LAS f32x4*)(F.lds + MISC_OFF + 1024);
    for (int tile = hidx; tile < N / 16; tile += nh) {
        f32x4 acc = (f32x4){0.f, 0.f, 0.f, 0.f};
        const bf16_t* wrow = Wt + (size_t)(tile * 16 + fr) * K + 8 * fq;
        const int kbeg = F.wave * steps * 32;
#pragma unroll 2
        for (int s = 0; s < steps; ++s) {
            const int k0 = kbeg + s * 32;
            const bf16x8 b = *(const bf16x8*)(wrow + k0);
            bf16x8 a;
            if (ABF16) a = *(const bf16x8*)((const bf16_t*)A1 + (size_t)fr * K + k0 + 8 * fq);
            else {
                const float* p = (const float*)A1 + (size_t)fr * K + k0 + 8 * fq;
                f32x4 x0 = *(const f32x4*)p, x1 = *(const f32x4*)(p + 4);
                if (A2) { const float* q = A2 + (size_t)fr * K + k0 + 8 * fq; x0 += *(const f32x4*)q; x1 += *(const f32x4*)(q + 4); }
                const v4u w = (v4u){pk2(x0.x, x0.y), pk2(x0.z, x0.w), pk2(x1.x, x1.y), pk2(x1.z, x1.w)};
                a = __builtin_bit_cast(bf16x8, w);
            }
            acc = __builtin_amdgcn_mfma_f32_16x16x32_bf16(a, b, acc, 0, 0, 0);
        }
        red[F.wave * 64 + lane] = acc;
        __syncthreads();
        if (F.tid < 64) {
            f32x4 s = red[lane];
#pragma unroll
            for (int w = 1; w < NWAVES; ++w) s += red[w * 64 + lane];
#pragma unroll
            for (int e = 0; e < 4; ++e) out[(size_t)(4 * fq + e) * N + tile * 16 + fr] = s[e];
        }
        __syncthreads();
    }
}

__device__ __forceinline__ void ffn_convert(Frame& F, const Args& a, int layer, int gw, int ngw) {
    F.refresh(); unsigned char* ws = F.ws;
    const float* g = a.in[I_FFNNORM] + (size_t)layer * D;
    conv_matrix<0>(F, a.in[I_FFNWG] + (size_t)layer * D * FF, FF, D, FF, (bf16_t*)(ws + WS_WG), g, gw, ngw);
    conv_matrix<0>(F, a.in[I_FFNWU] + (size_t)layer * D * FF, FF, D, FF, (bf16_t*)(ws + WS_WU), g, gw, ngw);
    conv_matrix<0>(F, a.in[I_FFNWD] + (size_t)layer * FF * D, D, FF, D, (bf16_t*)(ws + WS_WD), nullptr, gw, ngw);
}


__device__ __forceinline__ void hg_convert(Frame& F, const Args& args, int gw, int NGW);
#ifndef ALIGN_UP
#define ALIGN_UP true
#endif
#ifndef ALIGN_IN
#define ALIGN_IN true
#endif
#ifndef ALIGN_GATE
#define ALIGN_GATE true
#endif
#ifndef UP_ORDER
#define UP_ORDER pg8::StaticOrder
#endif
#ifndef SKIP_LOG2
#define SKIP_LOG2 48.f
#endif
#ifndef ATTN_THRL
#define ATTN_THRL 32
#endif
#ifndef FOXOUT_BASE
#define FOXOUT_BASE nullptr
#endif
struct Ptrs { float* SSQ; bf16_t* HB; float *HMA, *HMB, *MW, *MW2, *MW3, *MWG, *MWU, *MSSQ; bf16_t *MY, *MA; };

template <int LAYER> __device__ __forceinline__ void phase_gate(Frame& F, const Args& args, const Ptrs& P) {
    F.refresh(); unsigned char* ws = F.ws;
    auto pre = [&]() {
    if (F.G == 256) {
        side_gemm_wg<false>(F, P.HMA, P.MW2, (const bf16_t*)(ws + WS_WG), FF, D, P.MWG, F.bid, F.G);
        if (LAYER == 0) side_gemm_wg<false>(F, P.HMA, P.MW2, (const bf16_t*)(ws + WS_WU), FF, D, P.MWU, F.bid >= FF / 16 ? F.bid - FF / 16 : F.bid + (256 - FF / 16), F.G);
    } else {
        const int hfirst = (F.G * 3) / 4;
        if (F.bid >= hfirst) {
            const int nh = F.G - hfirst, hidx = F.bid - hfirst;
            side_gemm_wg<false>(F, P.HMA, P.MW2, (const bf16_t*)(ws + WS_WG), FF, D, P.MWG, hidx, nh);
            side_gemm_wg<false>(F, P.HMA, P.MW2, (const bf16_t*)(ws + WS_WU), FF, D, P.MWU, hidx, nh);
        }
    } };
    if (F.bid == F.G - 1) meta_consolidate(P.HMA, P.MW2, P.HMB, P.MSSQ, F.wave, F.lane);
    pg8::Gemm g{P.HB, (const bf16_t*)(ws + WS_WG), M, FF, D}; pg8::PartOrder S; S.init(M, FF, F.G, F.bid);
    EpiGate E{(bf16_t*)(ws + WS_A), P.SSQ};
    pre(); __syncthreads();
    pg8::gemm_phase<EpiGate, pg8::PartOrder, ALIGN_GATE, true, true>(F.lds, g, S, E, F.tid);
}
template <int LAYER> __device__ __forceinline__ void phase_up(Frame& F, const Args& args, const Ptrs& P) {
    F.refresh(); unsigned char* ws = F.ws;
    const float* cw = args.in[I_FFNCW] + (size_t)LAYER * 3 * FF; const float* cb = args.in[I_FFNCB] + (size_t)LAYER * FF;
#ifndef TEST_BUILD
    { const int hfirst = (F.G * 3) / 4;
      if (LAYER == 0 && F.bid >= hfirst) { hg_convert(F, args, (F.bid - hfirst) * NWAVES + F.wave, (F.G - hfirst) * NWAVES); __syncthreads(); } }
#endif
    { const int hfirst = (F.G * 3) / 4;
      if (LAYER == 0 && F.bid >= hfirst) {
        for (int idx = (F.bid - hfirst) * NTHREADS + F.tid; idx < NMETA * FF; idx += (F.G - hfirst) * NTHREADS) {
            const int m = idx / FF, f = idx - m * FF;
            const float r0 = rsqrtf(P.MSSQ[m] * (1.f / D) + EPS);
            float z = cb[f] + cw[2 * FF + f] * r0 * P.MWG[(size_t)m * FF + f];
            if (m >= 1) z += cw[FF + f] * rsqrtf(P.MSSQ[m - 1] * (1.f / D) + EPS) * P.MWG[(size_t)(m - 1) * FF + f];
            if (m >= 2) z += cw[f] * rsqrtf(P.MSSQ[m - 2] * (1.f / D) + EPS) * P.MWG[(size_t)(m - 2) * FF + f];
            P.MY[idx] = (bf16_t)f2bf(z * sigm(z) * r0 * P.MWU[(size_t)m * FF + f]);
        }
      } }
    pg8::Gemm g{P.HB, (const bf16_t*)(ws + WS_WU), M, FF, D};
    EpiUp E{(const bf16_t*)(ws + WS_A), (bf16_t*)(ws + WS_Y), P.SSQ, cw, cb, P.MWG, P.MSSQ};
    if constexpr (LAYER == 1) { pg8::PartOrder S; S.init(M, FF, F.G, F.bid); pg8::gemm_phase<EpiUp, pg8::PartOrder, ALIGN_UP, true, true>(F.lds, g, S, E, F.tid); }
    else { UP_ORDER S; S.init(M, FF, F.G, F.bid); pg8::gemm_phase<EpiUp, UP_ORDER, ALIGN_UP, true>(F.lds, g, S, E, F.tid); }
}
template <int LAYER> __device__ __forceinline__ void phase_down(Frame& F, const Args& args, const Ptrs& P) {
    F.refresh(); unsigned char* ws = F.ws;
    auto pre = [&]() { if (LAYER == 0 && F.bid < 64) { side_gemm_wg<true>(F, P.MY, nullptr, (const bf16_t*)(ws + WS_WD), D, FF, P.MW3, F.bid, 64); } };
    pg8::Gemm g{(const bf16_t*)(ws + WS_Y), (const bf16_t*)(ws + WS_WD), M, D, FF}; pg8::StaticOrder S; S.init(M, D, F.G, F.bid);
    EpiRes E{nullptr, LAYER ? args.out : nullptr, P.HB, LAYER ? nullptr : P.SSQ};
    pg8::gemm_phase<EpiRes, pg8::StaticOrder, false, true, false>(F.lds, g, S, E, F.tid, pre);
}

__device__ __forceinline__ void phase_prologue(Frame& F, const Args& args, const Ptrs& P, int gw, int NGW) {
    F.refresh(); unsigned char* ws = F.ws;
    conv_matrix<1>(F, args.in[I_FOXWIN], NIN, D, 4 * D, (bf16_t*)(ws + WS_WIN), args.in[I_FOXNORM], gw, NGW);
    for (int i = F.bid * NTHREADS + F.tid; i < D; i += F.G * NTHREADS) ((float*)(ws + MT_LB))[i] = sigm(args.in[I_HGLB][D + i] - args.in[I_HGLB][i]);
    { v4u* K4 = (v4u*)(ws + WS_K); v4u* V4 = (v4u*)(ws + WS_V); constexpr int PERB = KV_META0 * D * 2 / 16, STR = KVROWS * D * 2 / 16;
      for (int i = F.bid * NTHREADS + F.tid; i < NB * PERB; i += F.G * NTHREADS) { const int b = i / PERB, o = i - b * PERB; K4[(size_t)b * STR + o] = (v4u){0u, 0u, 0u, 0u}; V4[(size_t)b * STR + o] = (v4u){0u, 0u, 0u, 0u}; } }
    __syncthreads();
    LAS float* wfl = (LAS float*)F.lds;
    { float wv[32], gv[32];
#pragma unroll
      for (int i = 0; i < 32; ++i) { const int idx = F.tid + NTHREADS * i, kk = idx >> 4, h = idx & 15; wv[i] = args.in[I_FOXWIN][(size_t)kk * NIN + 3 * D + h]; gv[i] = args.in[I_FOXNORM][kk]; }
#pragma unroll
      for (int i = 0; i < 32; ++i) { const int idx = F.tid + NTHREADS * i, kk = idx >> 4, h = idx & 15; wfl[h * D + (kk ^ (4 * h))] = gv[i] * wv[i]; } }
    __syncthreads();
    float* LOGF = (float*)(ws + WS_LOGF);
    {
        LAS float* xt = wfl + 16 * D;
        LAS f32x4* part = (LAS f32x4*)(F.lds + MISC_OFF + 1024);
        LAS float* rss = (LAS float*)(part + 8 * 64);
        const int lane = F.lane, w = F.wave, r = lane & 15, kq = lane >> 4;
        constexpr int NG = (M + NMETA) / 16;
        f32x4 vc[2][4], vn[2][4];
        auto rowsrc = [&](int grow) { return grow < M ? args.in[I_X] + (size_t)grow * D : args.in[I_META] + (size_t)(grow - M) * D; };
        int gidx = F.bid;
        if (gidx < NG) {
#pragma unroll
            for (int q = 0; q < 2; ++q) row_load4n(rowsrc(16 * gidx + 2 * w + q), vc[q], lane); }
        for (int it = 0; gidx < NG; ++it, gidx += F.G) {
            const int gnext = gidx + F.G; const int pb = it & 1;
            if (gnext < NG) {
#pragma unroll
                for (int q = 0; q < 2; ++q) row_load4n(rowsrc(16 * gnext + 2 * w + q), vn[q], lane); }
#pragma unroll
            for (int q = 0; q < 2; ++q) {
                const int rt = 2 * w + q, grow = 16 * gidx + rt;
                float sq = 0.f;
#pragma unroll
                for (int j = 0; j < 4; ++j) { const f32x4 x = vc[q][j]; sq += (x.x * x.x + x.y * x.y) + (x.z * x.z + x.w * x.w); }
                sq = wave_sum(sq);
                if (grow < M) {
                    GAS unsigned long long* o8 = (GAS unsigned long long*)(P.HB + (size_t)grow * D) + lane;
#pragma unroll
                    for (int j = 0; j < 4; ++j) o8[64 * j] = (unsigned long long)pk2(vc[q][j].x, vc[q][j].y) | ((unsigned long long)pk2(vc[q][j].z, vc[q][j].w) << 32);
                    if (lane < 4) ((f32x4*)(P.SSQ + (size_t)grow * 16))[lane] = (lane == 0) ? (f32x4){sq, 0.f, 0.f, 0.f} : (f32x4){0.f, 0.f, 0.f, 0.f};
                } else {
#pragma unroll
                    for (int j = 0; j < 4; ++j) ((f32x4*)(P.HMA + (size_t)(grow - M) * D))[lane + 64 * j] = vc[q][j];
                    if (lane == 0) P.MSSQ[grow - M] = sq;
                }
#pragma unroll
                for (int j = 0; j < 4; ++j) *(LAS f32x4*)(xt + rt * D + ((4 * (lane + 64 * j)) ^ (4 * rt))) = vc[q][j];
                if (lane == 0) rss[pb * 16 + rt] = sq;
            }
            __syncthreads();
            {
                f32x4 acc = (f32x4){0.f, 0.f, 0.f, 0.f};
#pragma unroll
                for (int c = 0; c < 2; ++c) {
                    f32x4 wq[4], xq[4];
#pragma unroll
                    for (int i = 0; i < 4; ++i) { const int k0 = 128 * w + 64 * c + 16 * kq + 4 * i; wq[i] = *(const LAS f32x4*)(wfl + r * D + (k0 ^ (4 * r))); xq[i] = *(const LAS f32x4*)(xt + r * D + (k0 ^ (4 * r))); }
#pragma unroll
                    for (int i = 0; i < 4; ++i)
#pragma unroll
                        for (int e = 0; e < 4; ++e) acc = __builtin_amdgcn_mfma_f32_16x16x4f32(wq[i][e], xq[i][e], acc, 0, 0, 0);
                }
                part[w * 64 + lane] = acc;
            }
            __syncthreads();
            if (w == 0) {
                f32x4 acc = part[lane];
#pragma unroll
                for (int ww = 1; ww < 8; ++ww) acc += part[ww * 64 + lane];
                const int grow = 16 * gidx + r;
                const float rstd = rsqrtf(rss[pb * 16 + r] * (1.f / D) + EPS);
                const f32x4 bf = *(const f32x4*)(args.in[I_FOXBF] + 4 * kq);
#pragma unroll
                for (int e = 0; e < 4; ++e) { const int h = 4 * kq + e; const float xx = acc[e] * rstd + bf[e]; const float lf = fminf(xx, 0.f) - log1pf(__expf(-fabsf(xx)));
                    if (grow < M) { const int b = grow >> 13, ii = grow & (SEQ - 1); LOGF[(size_t)(b * H + h) * L + NMETA + ii] = lf; }
                    else { const int m = grow - M; LOGF[(size_t)h * L + m] = lf; LOGF[(size_t)(H + h) * L + m] = lf; } }
            }
#pragma unroll
            for (int q = 0; q < 2; ++q)
#pragma unroll
                for (int j = 0; j < 4; ++j) vc[q][j] = vn[q][j];
        }
    }
    __syncthreads();
}
__device__ __forceinline__ void phase_foxin(Frame& F, const Args& args, const Ptrs& P) {
    F.refresh(); unsigned char* ws = F.ws;
    auto pre = [&]() { side_gemm_wg<false>(F, P.HMA, nullptr, (const bf16_t*)(ws + WS_WIN), 4 * D, D, P.MW, F.bid, F.G); };
    pg8::Gemm g{P.HB, (const bf16_t*)(ws + WS_WIN), M, 4 * D, D}; pg8::StaticOrder S; S.init(M, 4 * D, F.G, F.bid);
    EpiFoxIn E{(bf16_t*)(ws + WS_Q), (bf16_t*)(ws + WS_K), (bf16_t*)(ws + WS_V), (bf16_t*)(ws + WS_GATE), P.SSQ, args.in[I_FOXQG], args.in[I_FOXKG]};
    pg8::gemm_phase<EpiFoxIn, pg8::StaticOrder, ALIGN_IN, true, false>(F.lds, g, S, E, F.tid, pre);
}
__device__ __forceinline__ void phase_scan(Frame& F, const Args& args, const Ptrs& P) {
    F.refresh(); unsigned char* ws = F.ws;
    const float* LOGF = (const float*)(ws + WS_LOGF); float* BIAS = (float*)(ws + WS_BIAS);
    if (F.bid < NB * H) {
        const float* lf = LOGF + (size_t)F.bid * L; float* bo = BIAS + (size_t)F.bid * KVROWS;
        LAS float* wsum = (LAS float*)F.lds;
        constexpr int PER = 17;
        float v[PER]; float s = 0.f;
#pragma unroll
        for (int j = 0; j < PER; ++j) { const int pos = PER * F.tid + j; v[j] = pos < L ? lf[pos] : 0.f; s += v[j]; }
        float incl = s;
#pragma unroll
        for (int o = 1; o < 64; o <<= 1) { const float n = __shfl_up(incl, o); if (F.lane >= o) incl += n; }
        if (F.lane == 63) wsum[F.wave] = incl;
        __syncthreads();
        float pre = 0.f;
        for (int w = 0; w < F.wave; ++w) pre += wsum[w];
        float run = pre + incl - s;
        LAS float* tend = (LAS float*)F.lds + 64; LAS float* tstart = tend + 160;
#pragma unroll
        for (int j = 0; j < PER; ++j) { const int pos = PER * F.tid + j, idx = KV_META0 + pos; run += v[j];
            if (pos < L) { const float bv = -run * LOG2E; bo[idx] = bv; if ((idx & 63) == 63) tend[idx >> 6] = bv; if ((idx & 63) == 0) tstart[idx >> 6] = bv; } }
        for (int r = F.tid; r < KV_META0; r += NTHREADS) bo[r] = BIAS_DUMMY;
        if (F.tid == 0) tend[0] = BIAS_DUMMY;
        asm volatile("s_waitcnt vmcnt(0)" ::: "memory"); __syncthreads();
        const float gqm = wave_max(fabsf(args.in[I_FOXQG][F.lane])), gkm = wave_max(fabsf(args.in[I_FOXKG][F.lane]));
        const float skipc = SKIP_LOG2 + 2.f * (8.f * gqm * gkm * 1.02f * LOG2E);
        if (F.tid < 32) {
            const int qb = F.tid, nchk = 4 * qb + 2; const float lim = tstart[(KV_MAIN0 >> 6) + 4 * qb] - skipc;
            int lo = 0, hi2 = nchk;
            while (lo < hi2) { const int mid = (lo + hi2) >> 1; if (tend[mid] < lim) lo = mid + 1; else hi2 = mid; }
            ((int*)(ws + MT_T0))[F.bid * 32 + qb] = lo & ~1;
        }
    } else if (F.bid > NB * H + 1) {
        const int cgw = (F.bid - NB * H - 2) * NWAVES + F.wave, cngw = (F.G - NB * H - 2) * NWAVES;
        conv_matrix<0>(F, args.in[I_FOXWOUT], D, D, D, (bf16_t*)(ws + WS_WOUT), nullptr, cgw, cngw);
        ffn_convert(F, args, 0, cgw, cngw);
    } else {
        LAS float* qn = (LAS float*)F.lds + F.wave * 2048; LAS float* kn = qn + 1024;
        const int d = F.lane, j = F.lane & 15, dg = F.lane >> 4;
        bf16_t* Kb = (bf16_t*)(ws + WS_K); bf16_t* Vb = (bf16_t*)(ws + WS_V);
        {
            const int h = F.wave + 8 * (F.bid - NB * H);
            const int st = 256 * (h >> 2) + 128 * (d >> 5) + 32 * (h & 3) + (d & 31);
            float qr[NMETA], kr[NMETA], vr[NMETA], gr[NMETA], rsm[NMETA];
            const float gqd = args.in[I_FOXQG][d], gkd = args.in[I_FOXKG][d];
#pragma unroll
            for (int m = 0; m < NMETA; ++m) {
                const float* row = P.MW + (size_t)m * 4 * D;
                qr[m] = row[st]; kr[m] = row[D + st]; vr[m] = row[2 * D + st]; gr[m] = row[3 * D + st]; rsm[m] = rsqrtf(P.MSSQ[m] * (1.f / D) + EPS);
            }
            float cmj = LOGF[(size_t)h * L + j];
            asm volatile("" ::: "memory");
#pragma unroll
            for (int o = 1; o < 16; o <<= 1) { const float n = __shfl_up(cmj, o, 16); if (j >= o) cmj += n; }
#pragma unroll
            for (int m = 0; m < NMETA; ++m) {
                const float rs = rsm[m];
                const float q = rs * qr[m], kk = rs * kr[m];
                const float sq = wave_sum(q * q), sk = wave_sum(kk * kk);
                const float qv = q * rsqrtf(sq * (1.f / HD) + EPS) * gqd * 0.125f, kv = kk * rsqrtf(sk * (1.f / HD) + EPS) * gkd;
                qn[m * 64 + d] = qv; kn[m * 64 + d] = kv; vr[m] = rs * vr[m]; gr[m] = sigm(rs * gr[m]);
#pragma unroll
                for (int b = 0; b < NB; ++b) { const size_t o = ((size_t)b * KVROWS + KV_META0 + m) * D + h * HD + d; Kb[o] = (bf16_t)f2bf(kv); Vb[o] = (bf16_t)f2bf(vr[m]); }
            }
            float pm[NMETA];
#pragma unroll
            for (int m = 0; m < NMETA; ++m) {
                float part = 0.f;
#pragma unroll
                for (int q4 = 0; q4 < 4; ++q4) { const f32x4 qa = *(const LAS f32x4*)(qn + m * 64 + 16 * dg + 4 * q4), ka = *(const LAS f32x4*)(kn + j * 64 + 16 * dg + 4 * q4); part += (qa.x * ka.x + qa.y * ka.y) + (qa.z * ka.z + qa.w * ka.w); }
                part += __shfl_xor(part, 16); part += __shfl_xor(part, 32);
                const float cmm = __shfl(cmj, m);
                const float sc = (j <= m) ? part + cmm - cmj : -INFINITY;
                const float mx = row16_max(sc);
                const float p = (j <= m) ? __expf(sc - mx) : 0.f; const float l = row16_sum(p);
                pm[m] = p * __builtin_amdgcn_rcpf(l);
            }
#pragma unroll
            for (int m = 0; m < NMETA; ++m) {
                float o = 0.f;
#pragma unroll
                for (int jj = 0; jj < NMETA; ++jj) if (jj <= m) o += __shfl(pm[m], jj) * vr[jj];
                P.MA[(size_t)m * D + h * HD + d] = (bf16_t)f2bf(o * gr[m]);
            }
        }
    }
}
__device__ __forceinline__ void phase_attn(Frame& F, const Args& args, const Ptrs& P, unsigned char* lds_generic) {
    F.refresh(); unsigned char* ws = F.ws;
    if (F.bid < 64) side_gemm_wg<true>(F, P.MA, nullptr, (const bf16_t*)(ws + WS_WOUT), D, D, P.MW2, F.bid, 64);
    const float gqm = wave_max(fabsf(args.in[I_FOXQG][F.lane])), gkm = wave_max(fabsf(args.in[I_FOXKG][F.lane]));
    const float smax2 = 8.f * gqm * gkm * 1.02f * LOG2E;
    const float skipc = SKIP_LOG2 + 2.f * smax2;
    const attn_body::AttnTensors AT{(const attn_body::bf16*)(ws + WS_Q), (const attn_body::bf16*)(ws + WS_K), (const attn_body::bf16*)(ws + WS_V), (attn_body::bf16*)(ws + WS_Q),
                                    (const float*)(ws + WS_BIAS), (const attn_body::bf16*)(ws + WS_GATE), skipc, (const int*)(ws + MT_T0)};
    const attn_body::StaticOrder S((int)F.G, (int)F.bid);
    attn_body::attn_phase<attn_body::StaticOrder, ATTN_THRL>((char*)lds_generic, AT, S, F.tid);
}
__device__ __forceinline__ void phase_foxout(Frame& F, const Args& args, const Ptrs& P) {
    F.refresh(); unsigned char* ws = F.ws;
    pg8::Gemm g{(const bf16_t*)(ws + WS_Q), (const bf16_t*)(ws + WS_WOUT), M, D, D}; pg8::StaticOrder S; S.init(M, D, F.G, F.bid);
    EpiRes E{FOXOUT_BASE, nullptr, P.HB, P.SSQ};
    pg8::gemm_phase<EpiRes, pg8::StaticOrder, false, true>(F.lds, g, S, E, F.tid);
}

__device__ __forceinline__ void hg_convert(Frame& F, const Args& args, int gw, int NGW) {
    conv_matrix<0>(F, args.in[I_HGWIN], 4 * D, D, 4 * D, (bf16_t*)(F.ws + WS_WIN), args.in[I_HGNORM], gw, NGW);
    conv_matrix<0>(F, args.in[I_HGWOUT], D, D, D, (bf16_t*)(F.ws + WS_WOUT), nullptr, gw, NGW);
}
__device__ __forceinline__ void phase_hgin(Frame& F, const Args& args, const Ptrs& P) {
    F.refresh(); unsigned char* ws = F.ws;
    auto pre = [&]() { side_gemm_wg<false>(F, P.HMB, P.MW3, (const bf16_t*)(ws + WS_WIN), 4 * D, D, P.MW, F.bid, F.G); };
    if (F.bid == F.G - 1) meta_consolidate(P.HMB, P.MW3, P.HMA, P.MSSQ, F.wave, F.lane);
    pg8::Gemm g{P.HB, (const bf16_t*)(ws + WS_WIN), M, 4 * D, D}; pg8::StaticOrder S; S.init(M, 4 * D, F.G, F.bid);
    EpiHgIn E{(bf16_t*)(ws + WS_QH), (bf16_t*)(ws + WS_VH), (bf16_t*)(ws + WS_G), (_Float16*)(ws + WS_LF), P.SSQ, (const float*)(ws + MT_LB)};
    pre(); __syncthreads();
    pg8::gemm_phase<EpiHgIn, pg8::StaticOrder, ALIGN_IN, true>(F.lds, g, S, E, F.tid);
}
__device__ __forceinline__ hg::UnitCtx hg_ctx(Frame& F, const Args& args, const Ptrs& P) {
    unsigned char* ws = F.ws;
    return hg::UnitCtx{(const bf16_t*)(ws + WS_QH), (const _Float16*)(ws + WS_LF), (const bf16_t*)(ws + WS_VH), (const bf16_t*)(ws + WS_G), (bf16_t*)(ws + WS_QH), P.MW, P.MSSQ, (const float*)(ws + MT_LB), args.in[I_HGOG], P.MA};
}
__device__ __forceinline__ void phase_hg1(Frame& F, const Args& args, const Ptrs& P) {
    F.refresh(); const hg::UnitCtx C = hg_ctx(F, args, P);
    for (int i = 0, base = 0; base < NB * HH * hg::NSC; ++i, base += F.G) { const int u = base + (F.bid + 16 * i) % F.G;
        if (u < NB * HH * hg::NSC) hg::unit<false>(F, C, u, (float*)args.out, (float*)(F.ws + WS_HDEC)); }
}
__device__ __forceinline__ void phase_hg2(Frame& F, const Args& args, const Ptrs& P) {
    F.refresh();
#ifndef TEST_BUILD
    ffn_convert(F, args, 1, F.bid * NWAVES + F.wave, F.G * NWAVES);
#endif
    hg::scan(F, (float*)args.out, (const float*)(F.ws + WS_HDEC));
}
__device__ __forceinline__ void phase_hg3(Frame& F, const Args& args, const Ptrs& P) {
    F.refresh(); const hg::UnitCtx C = hg_ctx(F, args, P);
    for (int i = 0, base = 0; base < NB * HH * hg::NSC; ++i, base += F.G) { const int u = base + (F.bid + 16 * i) % F.G;
        if (u < NB * HH * hg::NSC) hg::unit<true>(F, C, u, (float*)args.out, (float*)(F.ws + WS_HDEC)); }
}
__device__ __forceinline__ void phase_hgout(Frame& F, const Args& args, const Ptrs& P) {
    F.refresh(); unsigned char* ws = F.ws;
    auto pre = [&]() { if (F.bid < 64) side_gemm_wg<true>(F, P.MA, nullptr, (const bf16_t*)(ws + WS_WOUT), D, D, P.MW2, F.bid, 64); };
    pg8::Gemm g{(const bf16_t*)(ws + WS_QH), (const bf16_t*)(ws + WS_WOUT), M, D, D}; pg8::StaticOrder S; S.init(M, D, F.G, F.bid);
    EpiRes E{nullptr, nullptr, P.HB, P.SSQ};
    pg8::gemm_phase<EpiRes, pg8::StaticOrder, false, true, false>(F.lds, g, S, E, F.tid, pre);
}

__global__ void __launch_bounds__(NTHREADS, 2) mk_fwd(Args args) {
    extern __shared__ __attribute__((aligned(16))) unsigned char lds_raw[];
    Frame F;
    F.lds = (LAS unsigned char*)lds_raw; F.wave = __builtin_amdgcn_readfirstlane((int)threadIdx.x >> 6); F.refresh();
    F.G = gridDim.x; F.bid = blockIdx.x; F.ws = args.ws;
    unsigned char* ws = args.ws;
    const int gw = F.bid * NWAVES + F.wave, NGW = F.G * NWAVES;
    Ptrs P;
    P.SSQ = (float*)(ws + WS_SSQ); P.HB = (bf16_t*)(ws + WS_HB);
    P.HMA = (float*)(ws + MT_HMA); P.HMB = (float*)(ws + MT_HMB); P.MW = (float*)(ws + MT_MW); P.MW2 = (float*)(ws + MT_MW2); P.MW3 = (float*)(ws + MT_MW3);
    P.MWG = (float*)(ws + MT_MWG); P.MWU = (float*)(ws + MT_MWU); P.MSSQ = (float*)(ws + MT_MSSQ); P.MY = (bf16_t*)(ws + MT_MY); P.MA = (bf16_t*)(ws + MT_MA);
    const int lo = args.ph_lo, hi = args.ph_hi;
#define IN(k) (lo <= (k) && (k) < hi)
#ifdef TEST_BUILD
    if (IN(PH_T_FFNPREP0) || IN(PH_T_FFNPREP1)) {
        F.refresh();
        ffn_convert(F, args, IN(PH_T_FFNPREP1) ? 1 : 0, gw, NGW);
        for (int r = gw; r < M; r += NGW) row_to_bf16(args.out + (size_t)r * D, P.HB + (size_t)r * D, P.SSQ + (size_t)r * 16, F.lane);
        const float* nhm = (const float*)(ws + WS_NHM);
        for (int i = F.bid * NTHREADS + F.tid; i < NMETA * D; i += F.G * NTHREADS) { P.HMA[i] = nhm[i]; P.MW2[i] = 0.f; }
    }
#endif
#ifdef TEST_BUILD
    if (IN(PH_T_FFNPOST)) {
        F.refresh();
        float* nhm = (float*)(ws + WS_NHM);
        for (int i = F.bid * NTHREADS + F.tid; i < NMETA * D; i += F.G * NTHREADS) { const float v = P.HMB[i] + P.MW3[i]; nhm[i] = v; nhm[NMETA * D + i] = v; }
    }
#endif
#ifdef TEST_BUILD
    if (IN(PH_T_FOXPOST)) {
        F.refresh();
        float* nhm = (float*)(ws + WS_NHM);
        for (int i = F.bid * NTHREADS + F.tid; i < NMETA * D; i += F.G * NTHREADS) { const float v = P.HMA[i] + P.MW2[i]; nhm[i] = v; nhm[NMETA * D + i] = v; }
    }
#endif
    volatile LAS unsigned* MISC = (volatile LAS unsigned*)(F.lds + LDS_BYTES - 256);
    XcdBarrier bar; bar.bar = (unsigned*)(ws + WS_CTL) + 4096; bar.x = 0; bar.st = nullptr;
    const bool multi = (hi - lo > 1) && hi <= NPH;
    if (multi) { if (F.tid < 64) MISC[F.tid] = 0u; __syncthreads(); bar = xcd_barrier_post((unsigned*)(ws + WS_CTL) + 4096, MISC + 8, F.tid == 0); }
#ifdef ECHO_PH
#define PHASE(k, call) do { if (IN(k)) { const unsigned long long e0_ = __builtin_amdgcn_s_memrealtime(); call; if ((k) == ECHO_PH) { const unsigned long long e1_ = __builtin_amdgcn_s_memrealtime(), ed_ = e1_ - e0_; while (__builtin_amdgcn_s_memrealtime() - e1_ < ed_) __builtin_amdgcn_s_sleep(4); } } } while (0)
#else
#define PHASE(k, call) do { if (IN(k)) { call; } } while (0)
#endif
#define SEAM(k) do { if (IN(k) && IN((k) + 1)) { F.refresh(); xcd_barrier(bar, F.tid == 0); } } while (0)
    PHASE(PH_PRO, phase_prologue(F, args, P, gw, NGW));
    SEAM(PH_PRO);
    PHASE(PH_FOXIN, phase_foxin(F, args, P));
    SEAM(PH_FOXIN);
    PHASE(PH_SCAN, phase_scan(F, args, P));
    SEAM(PH_SCAN);
    PHASE(PH_ATTN, phase_attn(F, args, P, lds_raw));
    SEAM(PH_ATTN);
    PHASE(PH_FOXOUT, phase_foxout(F, args, P));
    SEAM(PH_FOXOUT);
    PHASE(PH_GATE0, phase_gate<0>(F, args, P));
    SEAM(PH_GATE0);
    PHASE(PH_UP0, phase_up<0>(F, args, P));
    SEAM(PH_UP0);
    PHASE(PH_DOWN0, phase_down<0>(F, args, P));
    SEAM(PH_DOWN0);
#ifdef TEST_BUILD
    if (IN(PH_T_HGPREP)) {
        F.refresh(); hg_convert(F, args, gw, NGW);
        for (int i = F.bid * NTHREADS + F.tid; i < D; i += F.G * NTHREADS) ((float*)(ws + MT_LB))[i] = sigm(args.in[I_HGLB][D + i] - args.in[I_HGLB][i]);
        for (int r = gw; r < M; r += NGW) row_to_bf16(args.out + (size_t)r * D, P.HB + (size_t)r * D, P.SSQ + (size_t)r * 16, F.lane);
        const float* nhm = (const float*)(ws + WS_NHM);
        for (int i = F.bid * NTHREADS + F.tid; i < NMETA * D; i += F.G * NTHREADS) { P.HMB[i] = nhm[i]; P.MW3[i] = 0.f; }
    }
#endif
    PHASE(PH_HGIN, phase_hgin(F, args, P));
    SEAM(PH_HGIN);
    PHASE(PH_HG1, phase_hg1(F, args, P));
    SEAM(PH_HG1);
    PHASE(PH_HG2, phase_hg2(F, args, P));
    SEAM(PH_HG2);
    PHASE(PH_HG3, phase_hg3(F, args, P));
    SEAM(PH_HG3);
    PHASE(PH_HGOUT, phase_hgout(F, args, P));
    SEAM(PH_HGOUT);
#ifdef TEST_BUILD
    if (IN(PH_T_HGPOST)) {
        F.refresh(); float* nhm = (float*)(ws + WS_NHM);
        for (int i = F.bid * NTHREADS + F.tid; i < NMETA * D; i += F.G * NTHREADS) { const float v = P.HMA[i] + P.MW2[i]; nhm[i] = v; nhm[NMETA * D + i] = v; }
    }
#endif
    PHASE(PH_GATE1, phase_gate<1>(F, args, P));
    SEAM(PH_GATE1);
    PHASE(PH_UP1, phase_up<1>(F, args, P));
    SEAM(PH_UP1);
    PHASE(PH_DOWN1, phase_down<1>(F, args, P));
}

#ifndef N_LAUNCH_PER_PHASE
#define N_LAUNCH_PER_PHASE 0
#endif
extern "C" void kernel_launch(void* const* d_in, const int* in_sizes, int n_in, void* d_out, int out_size, void* d_ws, size_t ws_size, hipStream_t stream) {
    static int grid = 0;
    if (grid == 0) {
        if (n_in != 19 || out_size != M * D || ws_size < WS_END) { fprintf(stderr, "kernel_launch: unexpected problem shape (n_in %d, out %d, ws %zu); nothing launched\n", n_in, out_size, ws_size); grid = -1; return; }
        int dev = 0, cus = 0, per_cu = 0;
        if (hipGetDevice(&dev) != hipSuccess || hipDeviceGetAttribute(&cus, hipDeviceAttributeMultiprocessorCount, dev) != hipSuccess) { grid = -1; return; }
        if (hipFuncSetAttribute((const void*)mk_fwd, hipFuncAttributeMaxDynamicSharedMemorySize, LDS_BYTES) != hipSuccess) { fprintf(stderr, "kernel_launch: hipFuncSetAttribute failed\n"); grid = -1; return; }
        if (hipOccupancyMaxActiveBlocksPerMultiprocessor(&per_cu, (const void*)mk_fwd, NTHREADS, LDS_BYTES) != hipSuccess || per_cu < 1) { fprintf(stderr, "kernel_launch: occupancy query reports %d workgroups per CU; nothing launched\n", per_cu); (void)hipGetLastError(); grid = -1; return; }
        grid = cus;
        if (grid != 256) fprintf(stderr, "kernel_launch: this kernel's static unit orders are built for 256 CUs; got %d\n", grid);
    }
    if (grid < 0) return;
    if (hipMemsetAsync((char*)d_ws + WS_CTL, 0, CTL_ZERO_BYTES, stream) != hipSuccess) return;
    Args a{};
    for (int i = 0; i < 19; ++i) a.in[i] = (const float*)d_in[i];
    a.out = (float*)d_out; a.ws = (unsigned char*)d_ws;
    if (N_LAUNCH_PER_PHASE) {
        for (int ph = 0; ph < NPH; ++ph) { a.ph_lo = ph; a.ph_hi = ph + 1; hipLaunchKernelGGL(mk_fwd, dim3(grid), dim3(NTHREADS), LDS_BYTES, stream, a); }
    } else {
        a.ph_lo = 0; a.ph_hi = NPH;
        hipLaunchKernelGGL(mk_fwd, dim3(grid), dim3(NTHREADS), LDS_BYTES, stream, a);
    }
}
```
